# Optimizing an MI355X kernel written in HIP

```python
import math
import jax, jax.numpy as jnp
from jax import lax
import numpy as np

D_MODEL = 1024
BATCH = 1
SEQ = 16384
DEPTH = 4

GRID_W = 64
CTX_LEN = 256
HEAD_DIM = 64
A_HEADS = 8
A_KV_HEADS = 2
B_HEADS = 8
NB_KH_MAX = 8
NB_KW = 16
C_HEADS = 16
C_KV_HEADS = 2
C_WINDOW = 128
Q_BLOCK = 128
D_FF = 2816
CONV_W = 3
ROPE_THETA = 10000.0
LN_EPS = 1e-5
RMS_EPS = 1e-6
NEG = -1e30
DN_ALPHA = (2 * DEPTH) ** 0.25
DN_BETA = (8 * DEPTH) ** -0.25
N_EVEN = (DEPTH + 1) // 2
N_ODD = DEPTH // 2
A_Q = A_HEADS * HEAD_DIM
A_KV = A_KV_HEADS * HEAD_DIM
B_W = B_HEADS * HEAD_DIM
EVEN_IN = A_Q + 2 * A_KV + 3 * B_W
EVEN_MIX = A_Q + B_W
C_Q = C_HEADS * HEAD_DIM
C_KV = C_KV_HEADS * HEAD_DIM
ODD_IN = C_Q + 2 * C_KV
ODD_MIX = C_Q

kernel_name = 'hybrid_dit_gqa_natten_swa_convffn'


def layer_norm(x, g, b):
    xf = x.astype(jnp.float32)
    mu = jnp.mean(xf, -1, keepdims=True)
    var = jnp.mean(jnp.square(xf - mu), -1, keepdims=True)
    return ((xf - mu) * lax.rsqrt(var + LN_EPS) * g + b).astype(x.dtype)


def rms_norm(x, g):
    xf = x.astype(jnp.float32)
    return (xf * lax.rsqrt(jnp.mean(xf * xf, -1, keepdims=True) + RMS_EPS) * g).astype(x.dtype)


def axial_rope_tables(n_tokens):
    t = jnp.arange(n_tokens, dtype=jnp.int32)
    row = (t // GRID_W).astype(jnp.float32)
    col = (t % GRID_W).astype(jnp.float32)
    half = HEAD_DIM // 2
    inv_freq = ROPE_THETA ** (-jnp.arange(0, half, 2, dtype=jnp.float32) / half)
    ang_r = row[:, None] * inv_freq
    ang_c = col[:, None] * inv_freq
    ang = jnp.concatenate([ang_r, ang_r, ang_c, ang_c], -1)
    return jnp.cos(ang), jnp.sin(ang)


def apply_rope(x, cos, sin):
    x1, x2, x3, x4 = jnp.split(x, 4, axis=-1)
    rot = jnp.concatenate([-x2, x1, -x4, x3], -1)
    return (x * cos[None, :, None, :] + rot * sin[None, :, None, :]).astype(x.dtype)


def heads(z, n):
    return z.reshape(z.shape[0], z.shape[1], n, HEAD_DIM)


def modulate(x, shift, scale):
    return x * (1 + scale) + shift


def gqa_scores(q, k):
    return jnp.einsum('bqkgd,btkd->bkgqt', q, k).astype(jnp.float32)


def gqa_out(p, v):
    return jnp.einsum('bkgqt,btkd->bqkgd', p.astype(v.dtype), v)


def global_gqa(q_lat, k_lat, v_lat, q_ctx, k_ctx, v_ctx, ctx_out):
    B, S, H, d = q_lat.shape
    KV = k_lat.shape[2]
    G = H // KV
    scale = d ** -0.5
    k_all = jnp.concatenate([k_ctx, k_lat], 1)
    v_all = jnp.concatenate([v_ctx, v_lat], 1)
    qb = (q_lat * scale).reshape(B, S // Q_BLOCK, Q_BLOCK, KV, G, d).swapaxes(0, 1)

    def block(q):
        p = jax.nn.softmax(gqa_scores(q, k_all), axis=-1)
        return gqa_out(p, v_all)

    o = lax.map(block, qb)
    y_lat = o.swapaxes(0, 1).reshape(B, S, H * d)
    y_ctx = None
    if ctx_out:
        qc = (q_ctx * scale).reshape(B, q_ctx.shape[1], KV, G, d)
        p = jax.nn.softmax(gqa_scores(qc, k_ctx), axis=-1)
        y_ctx = gqa_out(p, v_ctx).reshape(B, q_ctx.shape[1], H * d)
    return y_lat, y_ctx


def neighbourhood_attention(q_lat, k_lat, v_lat, q_ctx, k_ctx, v_ctx, rpb, ctx_out):
    B, S, H, d = q_lat.shape
    rows = S // GRID_W
    kh = min(NB_KH_MAX, rows)
    rb = Q_BLOCK // GRID_W
    scale = d ** -0.5
    col = jnp.arange(GRID_W)
    cs = jnp.clip(col - NB_KW // 2, 0, GRID_W - NB_KW)
    kcol = cs[:, None] + jnp.arange(NB_KW)
    dcol = kcol - col[:, None]
    qb = (q_lat * scale).reshape(B, rows // rb, rb, GRID_W, H, d).swapaxes(0, 1)
    n_nb = kh * NB_KW

    def block(args):
        qblk, blk = args
        row = blk * rb + jnp.arange(rb)
        rs = jnp.clip(row - kh // 2, 0, rows - kh)
        krow = rs[:, None] + jnp.arange(kh)
        drow = krow - row[:, None]
        idx = krow[:, None, :, None] * GRID_W + kcol[None, :, None, :]
        kn = k_lat[:, idx]
        vn = v_lat[:, idx]
        bias = rpb[:, drow[:, None, :, None] + NB_KH_MAX - 1, dcol[None, :, None, :] + NB_KW - 1]
        s_nb = jnp.einsum('brwhd,brwyxhd->bhrwyx', qblk, kn).astype(jnp.float32) + bias[None]
        s_nb = s_nb.reshape(B, H, rb, GRID_W, n_nb)
        s_ctx = jnp.einsum('brwhd,bthd->bhrwt', qblk, k_ctx).astype(jnp.float32)
        p = jax.nn.softmax(jnp.concatenate([s_nb, s_ctx], -1), axis=-1)
        p_nb = p[..., :n_nb].reshape(B, H, rb, GRID_W, kh, NB_KW).astype(vn.dtype)
        p_ctx = p[..., n_nb:].astype(v_ctx.dtype)
        return (jnp.einsum('bhrwyx,brwyxhd->brwhd', p_nb, vn)
                + jnp.einsum('bhrwt,bthd->brwhd', p_ctx, v_ctx))

    o = lax.map(block, (qb, jnp.arange(rows // rb)))
    y_lat = o.swapaxes(0, 1).reshape(B, S, H * d)
    y_ctx = None
    if ctx_out:
        s = jnp.einsum('bqhd,bthd->bhqt', q_ctx * scale, k_ctx).astype(jnp.float32)
        p = jax.nn.softmax(s, axis=-1).astype(v_ctx.dtype)
        y_ctx = jnp.einsum('bhqt,bthd->bqhd', p, v_ctx).reshape(B, q_ctx.shape[1], H * d)
    return y_lat, y_ctx


def window_gqa_sink(q_lat, k_lat, v_lat, q_ctx, k_ctx, v_ctx, sink, ctx_out):
    B, S, H, d = q_lat.shape
    KV = k_lat.shape[2]
    G = H // KV
    C = k_ctx.shape[1]
    scale = d ** -0.5
    span = Q_BLOCK + 2 * C_WINDOW
    pad = ((0, 0), (C_WINDOW, C_WINDOW), (0, 0), (0, 0))
    kp = jnp.pad(k_lat, pad)
    vp = jnp.pad(v_lat, pad)
    sink5 = sink.astype(jnp.float32).reshape(1, KV, G, 1, 1)
    qb = (q_lat * scale).reshape(B, S // Q_BLOCK, Q_BLOCK, KV, G, d).swapaxes(0, 1)
    qpos = jnp.arange(Q_BLOCK)
    kpos = jnp.arange(span) - C_WINDOW
    sink_q = jnp.broadcast_to(sink5, (B, KV, G, Q_BLOCK, 1))

    def block(args):
        q, blk = args
        start = blk * Q_BLOCK
        kb = lax.dynamic_slice_in_dim(kp, start, span, axis=1)
        vb = lax.dynamic_slice_in_dim(vp, start, span, axis=1)
        abs_k = start + kpos
        valid = ((jnp.abs(kpos[None, :] - qpos[:, None]) <= C_WINDOW)
                 & ((abs_k >= 0) & (abs_k < S))[None, :])
        s_loc = jnp.where(valid, gqa_scores(q, kb), NEG)
        s_ctx = gqa_scores(q, k_ctx)
        p = jax.nn.softmax(jnp.concatenate([s_loc, s_ctx, sink_q], -1), axis=-1)
        return gqa_out(p[..., :span], vb) + gqa_out(p[..., span:span + C], v_ctx)

    o = lax.map(block, (qb, jnp.arange(S // Q_BLOCK)))
    y_lat = o.swapaxes(0, 1).reshape(B, S, H * d)
    y_ctx = None
    if ctx_out:
        qc = (q_ctx * scale).reshape(B, C, KV, G, d)
        s = jnp.concatenate([gqa_scores(qc, k_ctx), jnp.broadcast_to(sink5, (B, KV, G, C, 1))], -1)
        p = jax.nn.softmax(s, axis=-1)
        y_ctx = gqa_out(p[..., :C], v_ctx).reshape(B, C, H * d)
    return y_lat, y_ctx


def even_project(h, w_in, q_gain, k_gain):
    qa, ka, va, qb, kb, vb = jnp.split(
        h @ w_in, [A_Q, A_Q + A_KV, A_Q + 2 * A_KV, A_Q + 2 * A_KV + B_W, A_Q + 2 * A_KV + 2 * B_W], axis=-1)
    return (rms_norm(heads(qa, A_HEADS), q_gain), rms_norm(heads(ka, A_KV_HEADS), k_gain),
            heads(va, A_KV_HEADS), heads(qb, B_HEADS), heads(kb, B_HEADS), heads(vb, B_HEADS))


def even_mixer(h_lat, h_ctx, w_in, w_out, q_gain, k_gain, rpb, cos, sin, ctx_out):
    qa, ka, va, qb, kb, vb = even_project(h_lat, w_in, q_gain, k_gain)
    qa_c, ka_c, va_c, qb_c, kb_c, vb_c = even_project(h_ctx, w_in, q_gain, k_gain)
    qa = apply_rope(qa, cos, sin)
    ka = apply_rope(ka, cos, sin)
    ya, ya_c = global_gqa(qa, ka, va, qa_c, ka_c, va_c, ctx_out)
    yb, yb_c = neighbourhood_attention(qb, kb, vb, qb_c, kb_c, vb_c, rpb, ctx_out)
    y_lat = jnp.concatenate([ya, yb], -1) @ w_out
    y_ctx = (jnp.concatenate([ya_c, yb_c], -1) @ w_out) if ctx_out else None
    return y_lat, y_ctx


def odd_project(h, w_in):
    q, k, v = jnp.split(h @ w_in, [C_Q, C_Q + C_KV], axis=-1)
    return heads(q, C_HEADS), heads(k, C_KV_HEADS), heads(v, C_KV_HEADS)


def odd_mixer(h_lat, h_ctx, w_in, w_out, sink, cos, sin, ctx_out):
    q, k, v = odd_project(h_lat, w_in)
    qc, kc, vc = odd_project(h_ctx, w_in)
    q = apply_rope(q, cos, sin)
    k = apply_rope(k, cos, sin)
    y, yc = window_gqa_sink(q, k, v, qc, kc, vc, sink, ctx_out)
    return y @ w_out, ((yc @ w_out) if ctx_out else None)


def conv_ffn(h, w_up, conv_w, conv_b, w_down):
    u = h @ w_up
    L = u.shape[1]
    r = CONV_W // 2
    up = jnp.pad(u, ((0, 0), (r, r), (0, 0)))
    acc = conv_b
    for j in range(CONV_W):
        acc = acc + up[:, j:j + L] * conv_w[j]
    a, g = jnp.split(acc, 2, axis=-1)
    return (jax.nn.silu(g) * a) @ w_down


def setup_inputs(seed: int = 0) -> dict:
    key = jax.random.key(seed)
    ks = jax.random.split(key, 24)
    nrm = jax.random.normal
    f32 = jnp.float32
    return {
        'x': nrm(ks[0], (BATCH, SEQ, D_MODEL), f32),
        'c': nrm(ks[1], (BATCH, D_MODEL), f32),
        'ctx': nrm(ks[2], (BATCH, CTX_LEN, D_MODEL), f32),
        'c_ctx': nrm(ks[3], (D_MODEL,), f32),
        'ada_w': nrm(ks[4], (DEPTH, D_MODEL, 6 * D_MODEL), f32) * (0.5 * D_MODEL ** -0.5),
        'ada_b': nrm(ks[5], (DEPTH, 6 * D_MODEL), f32) * 0.02,
        'ln_g': 1.0 + 0.02 * nrm(ks[6], (DEPTH, 2, D_MODEL), f32),
        'ln_b': 0.02 * nrm(ks[7], (DEPTH, 2, D_MODEL), f32),
        'ev_w_in': nrm(ks[8], (N_EVEN, D_MODEL, EVEN_IN), f32) * D_MODEL ** -0.5,
        'ev_w_out': nrm(ks[9], (N_EVEN, EVEN_MIX, D_MODEL), f32) * (EVEN_MIX ** -0.5 * DN_BETA),
        'ev_q_gain': 1.0 + 0.02 * nrm(ks[10], (N_EVEN, HEAD_DIM), f32),
        'ev_k_gain': 1.0 + 0.02 * nrm(ks[11], (N_EVEN, HEAD_DIM), f32),
        'ev_rpb': 0.5 * nrm(ks[12], (N_EVEN, B_HEADS, 2 * NB_KH_MAX - 1, 2 * NB_KW - 1), f32),
        'od_w_in': nrm(ks[13], (N_ODD, D_MODEL, ODD_IN), f32) * D_MODEL ** -0.5,
        'od_w_out': nrm(ks[14], (N_ODD, ODD_MIX, D_MODEL), f32) * (ODD_MIX ** -0.5 * DN_BETA),
        'od_sink': nrm(ks[15], (N_ODD, C_HEADS), f32),
        'ffn_w_up': nrm(ks[16], (DEPTH, D_MODEL, 2 * D_FF), f32) * D_MODEL ** -0.5,
        'ffn_conv_w': nrm(ks[17], (DEPTH, CONV_W, 2 * D_FF), f32) * CONV_W ** -0.5,
        'ffn_conv_b': 0.02 * nrm(ks[18], (DEPTH, 2 * D_FF), f32),
        'ffn_w_down': nrm(ks[19], (DEPTH, D_FF, D_MODEL), f32) * (D_FF ** -0.5 * DN_BETA),
    }


def reference(x, c, ctx, c_ctx, ada_w, ada_b, ln_g, ln_b, ev_w_in, ev_w_out, ev_q_gain, ev_k_gain, ev_rpb,
              od_w_in, od_w_out, od_sink, ffn_w_up, ffn_conv_w, ffn_conv_b, ffn_w_down):
    S = x.shape[1]
    cos, sin = axial_rope_tables(S)
    x_lat, x_ctx = x, ctx
    for l in range(DEPTH):
        ctx_out = l < DEPTH - 1
        i = l // 2
        m_lat = [m[:, None, :] for m in jnp.split(jax.nn.silu(c) @ ada_w[l] + ada_b[l], 6, axis=-1)]
        m_ctx = jnp.split(jax.nn.silu(c_ctx) @ ada_w[l] + ada_b[l], 6, axis=-1)
        h_lat = modulate(x_lat, m_lat[0], m_lat[1])
        h_ctx = modulate(x_ctx, m_ctx[0], m_ctx[1])
        if l % 2 == 0:
            y_lat, y_ctx = even_mixer(h_lat, h_ctx, ev_w_in[i], ev_w_out[i], ev_q_gain[i], ev_k_gain[i],
                                      ev_rpb[i], cos, sin, ctx_out)
        else:
            y_lat, y_ctx = odd_mixer(h_lat, h_ctx, od_w_in[i], od_w_out[i], od_sink[i], cos, sin, ctx_out)
        x_lat = layer_norm(DN_ALPHA * x_lat + m_lat[2] * y_lat, ln_g[l, 0], ln_b[l, 0])
        f_lat = conv_ffn(modulate(x_lat, m_lat[3], m_lat[4]), ffn_w_up[l], ffn_conv_w[l], ffn_conv_b[l], ffn_w_down[l])
        x_lat = layer_norm(DN_ALPHA * x_lat + m_lat[5] * f_lat, ln_g[l, 1], ln_b[l, 1])
        if ctx_out:
            x_ctx = layer_norm(DN_ALPHA * x_ctx + m_ctx[2] * y_ctx, ln_g[l, 0], ln_b[l, 0])
            f_ctx = conv_ffn(modulate(x_ctx, m_ctx[3], m_ctx[4]), ffn_w_up[l], ffn_conv_w[l], ffn_conv_b[l], ffn_w_down[l])
            x_ctx = layer_norm(DN_ALPHA * x_ctx + m_ctx[5] * f_ctx, ln_g[l, 1], ln_b[l, 1])
    return x_lat
```

```cpp
#include <hip/hip_runtime.h>
#include <hip/hip_cooperative_groups.h>
#include <hip/hip_bf16.h>
#include <cstdio>
#include <cstdint>
#include <cmath>
namespace cg = cooperative_groups;
namespace pg8 {
#define PG8_LAS __attribute__((address_space(3)))
typedef unsigned short bf16_t;
typedef short bf16x8 __attribute__((ext_vector_type(8)));
typedef float f32x4 __attribute__((ext_vector_type(4)));
typedef unsigned u32x4 __attribute__((ext_vector_type(4)));
constexpr int BM = 256, BK = 64, HALF = 128, HTB = HALF * BK * 2  , STAGE_BYTES = 8 * HTB, NXCD = 8, WGM = 8;

__host__ __device__ __forceinline__ int lds_byte(int r, int c) { const int st = (r >> 4) * 2 + (c >> 5), rr = r & 15, cc = c & 31, ob = rr * 64 + cc * 2; return st * 1024 + (ob ^ (((ob >> 9) & 1) << 5)); }
__host__ __device__ __forceinline__ void stage_rc(int b, int& R, int& C) { const int st = b / 1024, sb = b % 1024, swz = sb ^ (((sb >> 9) & 1) << 5); R = (st >> 1) * 16 + swz / 64; C = (st & 1) * 32 + (swz % 64) / 2; }
__host__ __device__ __forceinline__ int perm32(int rho) { const int n = rho >> 4, i = rho & 15; return 8 * (i >> 2) + 4 * n + (i & 3); }

struct Unit { int pm, pn; };
struct Gemm { const bf16_t* A; const bf16_t* Bt; int M, N, K; };

struct StaticOrder {
    int nM, nN, nwg, G, c;
    __host__ __device__ void init(int M, int N, int G_, int c_) { nM = M / BM; nN = N / BM; nwg = nM * nN; G = G_; c = c_; }
    __host__ __device__ bool next(int i, Unit& u) const {
        const long L = (long)i * G + c; if (L >= nwg) return false;
        int wgid = (int)L; { const int q = nwg / NXCD, r = nwg % NXCD, xcd = wgid % NXCD, off = wgid / NXCD; wgid = (xcd < r ? xcd * (q + 1) : r * (q + 1) + (xcd - r) * q) + off; }
        const int nig = WGM * nN, gid = wgid / nig, fm = gid * WGM, gsz = (nM - fm) < WGM ? (nM - fm) : WGM;
        u.pm = fm + ((wgid % nig) % gsz); u.pn = (wgid % nig) / gsz; return true;
    }
    __device__ __forceinline__ void a_ready(const Unit&) const {}
    __device__ __forceinline__ void done(const Unit&) const {}
};

__device__ __forceinline__ unsigned cvt_pk_bf16(float lo, float hi) { unsigned r; asm volatile("v_cvt_pk_bf16_f32 %0, %1, %2" : "=v"(r) : "v"(lo), "v"(hi)); return r; }
typedef float f32x2 __attribute__((ext_vector_type(2)));
__device__ __forceinline__ unsigned pk_bf16(float lo, float hi) { typedef float f2 __attribute__((ext_vector_type(2))); typedef __bf16 b2 __attribute__((ext_vector_type(2))); f2 v = {lo, hi}; b2 b = __builtin_convertvector(v, b2); return __builtin_bit_cast(unsigned, b); }

struct EpiInproj {
    static constexpr bool PERM = true, AFTER_DRAIN = false;
    bf16_t* O; int ldc;
    const float* qg; const float* kg;
    const float* cosT; const float* sinT;
    int rmsq_end, rms_end, rope_end, sc1_end, sc2_beg, sc2_end;
    float c2;
    __device__ __forceinline__ void operator()(const f32x4 (&acc)[2][2][4][2], const Unit& u, int wr, int wc, int fr, int fq) const {
        const int hb = u.pn * BM + wc * 64;
        const bool do_rms = hb < rms_end, do_rope = hb < rope_end;
        const float sc = (hb < sc1_end || (hb >= sc2_beg && hb < sc2_end)) ? c2 : 1.f;
        f32x4 gv[2][2];
#pragma unroll
        for (int bj = 0; bj < 2; ++bj)
#pragma unroll
            for (int n = 0; n < 2; ++n) gv[bj][n] = do_rms ? *(const f32x4*)((hb < rmsq_end ? qg : kg) + 32 * bj + 16 * n + 4 * fq) : (f32x4){1.f, 1.f, 1.f, 1.f};
#pragma unroll
        for (int ai = 0; ai < 2; ++ai)
#pragma unroll
            for (int m = 0; m < 4; ++m) {
                const int row = u.pm * BM + ai * HALF + wr * 64 + m * 16 + fr;
                f32x4 v[2][2];
#pragma unroll
                for (int bj = 0; bj < 2; ++bj)
#pragma unroll
                    for (int n = 0; n < 2; ++n) v[bj][n] = acc[ai][bj][m][n];
                if (do_rms) {
                    float ss = 0.f;
#pragma unroll
                    for (int bj = 0; bj < 2; ++bj)
#pragma unroll
                        for (int n = 0; n < 2; ++n) { const f32x4 x = v[bj][n]; ss += (x[0] * x[0] + x[1] * x[1]) + (x[2] * x[2] + x[3] * x[3]); }
                    ss += __shfl_xor(ss, 16); ss += __shfl_xor(ss, 32);
                    const float rinv = 1.0f / sqrtf(ss * (1.0f / 64.0f) + 1e-6f);
#pragma unroll
                    for (int bj = 0; bj < 2; ++bj)
#pragma unroll
                        for (int n = 0; n < 2; ++n) v[bj][n] = v[bj][n] * rinv * gv[bj][n];
                }
                if (do_rope && row < 16384) {
#pragma unroll
                    for (int bj = 0; bj < 2; ++bj) {
                        const int pos = bj ? (row & 63) : (row >> 6);
                        const f32x4 cs = *(const f32x4*)(cosT + pos * 16 + 4 * fq), sn = *(const f32x4*)(sinT + pos * 16 + 4 * fq);
                        const f32x4 x1 = v[bj][0], x2 = v[bj][1];
                        v[bj][0] = x1 * cs - x2 * sn; v[bj][1] = x2 * cs + x1 * sn;
                    }
                }
                bf16_t* rowp = O + (size_t)row * ldc + hb + 8 * fq;
#pragma unroll
                for (int bj = 0; bj < 2; ++bj) {
                    const f32x4 a = v[bj][0] * sc, b = v[bj][1] * sc;
                    u32x4 w; w.x = pk_bf16(a[0], a[1]); w.y = pk_bf16(a[2], a[3]); w.z = pk_bf16(b[0], b[1]); w.w = pk_bf16(b[2], b[3]);
                    *(u32x4*)(rowp + 32 * bj) = w;
                }
                asm volatile("" ::: "memory");
            }
    }
};
struct EpiResid {
    static constexpr bool PERM = true, AFTER_DRAIN = false;
    float* XS; const float* gate_lat; const float* gate_ctx; float alpha;
    __device__ __forceinline__ void operator()(const f32x4 (&acc)[2][2][4][2], const Unit& u, int wr, int wc, int fr, int fq) const {
        const float* gate = (u.pm >= 64) ? gate_ctx : gate_lat;
        const int col0 = u.pn * BM + wc * 32 + 8 * fq;
        f32x4 gv[2][2];
#pragma unroll
        for (int bj = 0; bj < 2; ++bj)
#pragma unroll
            for (int n = 0; n < 2; ++n) gv[bj][n] = *(const f32x4*)(gate + col0 + bj * HALF + 4 * n);
#pragma unroll
        for (int ai = 0; ai < 2; ++ai)
#pragma unroll
            for (int m = 0; m < 4; ++m) {
                float* rowp = XS + (size_t)(u.pm * BM + ai * HALF + wr * 64 + m * 16 + fr) * 1024 + col0;
#pragma unroll
                for (int bj = 0; bj < 2; ++bj)
#pragma unroll
                    for (int n = 0; n < 2; ++n) { f32x4* p = (f32x4*)(rowp + bj * HALF + 4 * n); const f32x4 x = *p; *p = x * alpha + gv[bj][n] * acc[ai][bj][m][n]; }
                if (m & 1) asm volatile("" ::: "memory");
            }
    }
};
struct EpiStore {
    static constexpr bool PERM = true, AFTER_DRAIN = false;
    bf16_t* O; int ldc;
    __device__ __forceinline__ void operator()(const f32x4 (&acc)[2][2][4][2], const Unit& u, int wr, int wc, int fr, int fq) const {
        const int col0 = u.pn * BM + wc * 32 + 8 * fq;
#pragma unroll
        for (int ai = 0; ai < 2; ++ai)
#pragma unroll
            for (int m = 0; m < 4; ++m) {
                bf16_t* rowp = O + (size_t)(u.pm * BM + ai * HALF + wr * 64 + m * 16 + fr) * ldc + col0;
#pragma unroll
                for (int bj = 0; bj < 2; ++bj) { const f32x4 a = acc[ai][bj][m][0], b = acc[ai][bj][m][1];
                    u32x4 w; w.x = pk_bf16(a[0], a[1]); w.y = pk_bf16(a[2], a[3]); w.z = pk_bf16(b[0], b[1]); w.w = pk_bf16(b[2], b[3]);
                    *(u32x4*)(rowp + bj * HALF) = w; }
            }
    }
};
template <class Epi, class Sched, bool ALIGN_EPI = false, bool SP2 = false>
__device__ __forceinline__ void gemm_phase(PG8_LAS unsigned char* lds, const Gemm g, const Sched& S, const Epi& E) {
    int tid = threadIdx.x; asm volatile("" : "+v"(tid));
    const int wid = __builtin_amdgcn_readfirstlane(tid >> 6), lane = tid & 63, wr = wid >> 2, wc = wid & 3, fr = lane & 15, fq = lane >> 4;
    const int K = g.K, nt = K / BK;
    unsigned voffA[2], voffB[2];
#pragma unroll
    for (int i = 0; i < 2; ++i) { int R, C; stage_rc(tid * 16 + i * 8192, R, C); const int Rb = Epi::PERM ? ((R & ~31) + perm32(R & 31)) : R;
        voffA[i] = (unsigned)(R * K + C) * 2u; voffB[i] = (unsigned)(Rb * K + C) * 2u; }
    const size_t kstep = (size_t)(BK * 2);
    const size_t hstep = (size_t)HALF * K * 2;
    const size_t tstep = 2 * hstep;
    const unsigned ldsw = (unsigned)wid * 1024u;
    const int aoff = lds_byte(wr * 64 + fr, fq * 8), boff = lds_byte(wc * 32 + fr, fq * 8);
#define PG8_SA(b, h) (((b) * 2 + (h)) * HTB)
#define PG8_SB(b, h) ((4 + (b) * 2 + (h)) * HTB)
#define PG8_STAGE(bufoff, gbase, voff) do { _Pragma("unroll") for (int _i = 0; _i < 2; ++_i) \
        __builtin_amdgcn_global_load_lds((const unsigned*)((const char*)(gbase) + (voff)[_i]), (PG8_LAS unsigned*)(lds + (bufoff) + ldsw + _i * 8192), 16, 0, 0); } while (0)
#define PG8_LDA(dst, b, h) do { _Pragma("unroll") for (int m = 0; m < 4; ++m) _Pragma("unroll") for (int k = 0; k < 2; ++k) dst[m][k] = *(const PG8_LAS bf16x8*)(lds + PG8_SA(b, h) + aoff + m * 2048 + k * 1024); } while (0)
#define PG8_LDB(dst, b, h) do { _Pragma("unroll") for (int n = 0; n < 2; ++n) _Pragma("unroll") for (int k = 0; k < 2; ++k) dst[n][k] = *(const PG8_LAS bf16x8*)(lds + PG8_SB(b, h) + boff + n * 2048 + k * 1024); } while (0)
#define PG8_MMA(ai, bj, At, Bt) do { __builtin_amdgcn_s_setprio(1); _Pragma("unroll") for (int m = 0; m < 4; ++m) _Pragma("unroll") for (int n = 0; n < 2; ++n) _Pragma("unroll") for (int k = 0; k < 2; ++k) \
        acc[ai][bj][m][n] = __builtin_amdgcn_mfma_f32_16x16x32_bf16(Bt[n][k], At[m][k], acc[ai][bj][m][n], 0, 0, 0); __builtin_amdgcn_s_setprio(0); } while (0)
#define PG8_WAIT_V(n) asm volatile("s_waitcnt vmcnt(" #n ")" ::: "memory")
#define PG8_WAIT_L(n) asm volatile("s_waitcnt lgkmcnt(" #n ")" ::: "memory")
#define PG8_BAR __builtin_amdgcn_s_barrier()
#define PG8_SCHED __builtin_amdgcn_sched_barrier(0)
    Unit cur, nxt; int ui = 0;
    if (!S.next(0, cur)) return;
    f32x4 acc[2][2][4][2];
#pragma unroll
    for (int a = 0; a < 2; ++a)
#pragma unroll
        for (int b = 0; b < 2; ++b)
#pragma unroll
            for (int m = 0; m < 4; ++m)
#pragma unroll
                for (int n = 0; n < 2; ++n) acc[a][b][m][n] = (f32x4){0.f, 0.f, 0.f, 0.f};
    bf16x8 At[4][2], B0[2][2], B1[2][2];
    const char* cA = (const char*)g.A + (size_t)cur.pm * tstep; const char* cB = (const char*)g.Bt + (size_t)cur.pn * tstep;
    S.a_ready(cur);
    if constexpr (SP2) {
        PG8_STAGE(PG8_SB(0, 0), cB, voffB); PG8_STAGE(PG8_SB(0, 1), cB + hstep, voffB); PG8_STAGE(PG8_SA(0, 0), cA, voffA); PG8_STAGE(PG8_SA(0, 1), cA + hstep, voffA);
        if (wr == 1) PG8_BAR;
        PG8_WAIT_V(2); PG8_BAR;
        PG8_STAGE(PG8_SB(1, 0), cB + kstep, voffB); PG8_STAGE(PG8_SA(1, 0), cA + kstep, voffA); PG8_STAGE(PG8_SB(1, 1), cB + hstep + kstep, voffB);
        PG8_WAIT_V(6); PG8_BAR;
    } else {
        PG8_STAGE(PG8_SB(0, 0), cB, voffB); PG8_STAGE(PG8_SA(0, 0), cA, voffA); PG8_STAGE(PG8_SB(0, 1), cB + hstep, voffB); PG8_STAGE(PG8_SA(0, 1), cA + hstep, voffA);
        if (wr == 1) PG8_BAR;
        PG8_WAIT_V(4); PG8_BAR;
        PG8_STAGE(PG8_SB(1, 0), cB + kstep, voffB); PG8_STAGE(PG8_SA(1, 0), cA + kstep, voffA); PG8_STAGE(PG8_SB(1, 1), cB + hstep + kstep, voffB);
        PG8_WAIT_V(6); PG8_BAR;
    }
    for (;;) {
        const bool has_next = S.next(ui + 1, nxt);
        const char* nA = has_next ? (const char*)g.A + (size_t)nxt.pm * tstep : cA; const char* nB = has_next ? (const char*)g.Bt + (size_t)nxt.pn * tstep : cB;
        for (int t = 0; t < nt; t += 2) {
            const bool last = (t == nt - 2);
            const char* a1 = cA + (size_t)(t + 1) * kstep;
            const char* a2 = last ? nA : cA + (size_t)(t + 2) * kstep; const char* b2 = last ? nB : cB + (size_t)(t + 2) * kstep;
            const char* a3 = a2 + kstep; const char* b3 = b2 + kstep;
            if (last && has_next) S.a_ready(nxt);
            if constexpr (SP2) {
            PG8_LDB(B0, 0, 0); PG8_LDB(B1, 0, 1); PG8_SCHED; PG8_LDA(At, 0, 0); PG8_STAGE(PG8_SA(1, 1), a1 + hstep, voffA);
            PG8_WAIT_V(8); PG8_WAIT_L(0); PG8_BAR; PG8_MMA(0, 0, At, B0); PG8_MMA(0, 1, At, B1); PG8_BAR; PG8_SCHED;
            PG8_LDA(At, 0, 1); PG8_STAGE(PG8_SB(0, 0), b2, voffB); PG8_STAGE(PG8_SB(0, 1), b2 + hstep, voffB); PG8_STAGE(PG8_SA(0, 0), a2, voffA);
            PG8_WAIT_V(8); PG8_WAIT_L(0); PG8_BAR; PG8_MMA(1, 0, At, B0); PG8_MMA(1, 1, At, B1); PG8_BAR; PG8_SCHED;
            PG8_LDB(B0, 1, 0); PG8_LDB(B1, 1, 1); PG8_SCHED; PG8_LDA(At, 1, 0); PG8_STAGE(PG8_SA(0, 1), a2 + hstep, voffA);
            PG8_WAIT_V(8); PG8_WAIT_L(0); PG8_BAR; PG8_MMA(0, 0, At, B0); PG8_MMA(0, 1, At, B1); PG8_BAR; PG8_SCHED;
            PG8_LDA(At, 1, 1); PG8_STAGE(PG8_SB(1, 0), b3, voffB); PG8_STAGE(PG8_SB(1, 1), b3 + hstep, voffB); PG8_STAGE(PG8_SA(1, 0), a3, voffA);
            PG8_WAIT_V(8); PG8_WAIT_L(0); PG8_BAR; PG8_MMA(1, 0, At, B0); PG8_MMA(1, 1, At, B1); PG8_BAR; PG8_SCHED;
            } else {
            PG8_LDB(B0, 0, 0); PG8_SCHED; PG8_LDA(At, 0, 0); PG8_STAGE(PG8_SA(1, 1), a1 + hstep, voffA);
            PG8_WAIT_L(8); PG8_BAR; PG8_WAIT_L(0); PG8_MMA(0, 0, At, B0); PG8_BAR; PG8_SCHED;
            PG8_LDB(B1, 0, 1); PG8_STAGE(PG8_SB(0, 0), b2, voffB);
            PG8_BAR; PG8_WAIT_L(0); PG8_MMA(0, 1, At, B1); PG8_BAR;
            PG8_LDA(At, 0, 1); PG8_STAGE(PG8_SA(0, 0), a2, voffA);
            PG8_BAR; PG8_WAIT_L(0); PG8_MMA(1, 0, At, B0); PG8_BAR; PG8_SCHED;
            PG8_STAGE(PG8_SB(0, 1), b2 + hstep, voffB);
            PG8_WAIT_V(6); PG8_BAR; PG8_MMA(1, 1, At, B1); PG8_BAR;
            PG8_LDB(B0, 1, 0); PG8_SCHED; PG8_LDA(At, 1, 0); PG8_STAGE(PG8_SA(0, 1), a2 + hstep, voffA);
            PG8_WAIT_L(8); PG8_BAR; PG8_WAIT_L(0); PG8_MMA(0, 0, At, B0); PG8_BAR; PG8_SCHED;
            PG8_LDB(B1, 1, 1); PG8_STAGE(PG8_SB(1, 0), b3, voffB);
            PG8_BAR; PG8_WAIT_L(0); PG8_MMA(0, 1, At, B1); PG8_BAR;
            PG8_LDA(At, 1, 1); PG8_STAGE(PG8_SA(1, 0), a3, voffA);
            PG8_BAR; PG8_WAIT_L(0); PG8_MMA(1, 0, At, B0); PG8_BAR; PG8_SCHED;
            PG8_STAGE(PG8_SB(1, 1), b3 + hstep, voffB);
            PG8_WAIT_V(6); PG8_BAR; PG8_MMA(1, 1, At, B1); PG8_BAR;
            }
        }
        if constexpr (ALIGN_EPI) { if (wr == 0) PG8_BAR; }
        if constexpr (!Epi::AFTER_DRAIN) { E(acc, cur, wr, wc, fr, fq); S.done(cur); }
        if (!has_next) break;
#pragma unroll
        for (int a = 0; a < 2; ++a)
#pragma unroll
            for (int b = 0; b < 2; ++b)
#pragma unroll
                for (int m = 0; m < 4; ++m)
#pragma unroll
                    for (int n = 0; n < 2; ++n) acc[a][b][m][n] = (f32x4){0.f, 0.f, 0.f, 0.f};
        cur = nxt; cA = nA; cB = nB; ++ui;
        if constexpr (ALIGN_EPI) { if (wr == 1) PG8_BAR; }
    }
    PG8_WAIT_V(0);
    if constexpr (!ALIGN_EPI) { if (wr == 0) PG8_BAR; }
    PG8_BAR;
    if constexpr (Epi::AFTER_DRAIN) { E.fused(acc, cur, wr, wc, fr, fq, lds, wid, lane); S.done(cur); }
#undef PG8_SA
#undef PG8_SB
#undef PG8_STAGE
#undef PG8_LDA
#undef PG8_LDB
#undef PG8_MMA
#undef PG8_WAIT_V
#undef PG8_WAIT_L
#undef PG8_BAR
#undef PG8_SCHED
}
}
namespace attn_body {
using bf16=__hip_bfloat16;
using bf16x8=__attribute__((ext_vector_type(8)))short;
using s16x4=__attribute__((ext_vector_type(4)))short;
using f32x16=__attribute__((ext_vector_type(16)))float;
using u32x4=__attribute__((ext_vector_type(4)))unsigned;
constexpr int D=64,QP=2304,KP=2304,OP=1024,NTILES=260;
constexpr int NW=8,QBLK=32,QB=QBLK*NW,KVBLK=64;
__device__ __forceinline__ int crow(int r,int hi){return (r&3)+8*(r>>2)+4*hi;}
#define SBAR() __builtin_amdgcn_sched_barrier(0)
__device__ __forceinline__ void cmask(f32x16&p0,f32x16&p1,int jb,int qrel,int hi){
  const float NEG=-INFINITY; int kb=64*jb+4*hi;
  #pragma unroll
  for(int r=0;r<16;++r){int kv=kb+(r&3)+8*(r>>2); if(kv>qrel)p0[r]=NEG; if(kv+32>qrel)p1[r]=NEG;}
}

constexpr int NSLOT=3, SLOTB=8192;
constexpr int LDS_K=0, LDS_V=NSLOT*SLOTB, LDS_WS=2*NSLOT*SLOTB, LDS_OST=LDS_WS+NW*64*4, LDS_BYTES=LDS_OST+NW*4096;
constexpr float C2=0.125f*1.4426950408889634f;
__device__ __forceinline__ void glds16(const void*gsrc,unsigned lds_dst){unsigned keep;
  asm volatile("s_mov_b32 %0, m0\n\ts_mov_b32 m0, %2\n\ts_nop 0\n\tglobal_load_lds_dwordx4 %1, off\n\ts_mov_b32 m0, %0":"=&s"(keep):"v"(gsrc),"s"(lds_dst):"memory");}
__device__ __forceinline__ float max3f(float a,float b,float c){float r;asm("v_max3_f32 %0, %1, %2, %3":"=v"(r):"v"(a),"v"(b),"v"(c));return r;}
__device__ __forceinline__ float max2f(float a,float b){float r;asm("v_max_f32_e32 %0, %1, %2":"=v"(r):"v"(a),"v"(b));return r;}
__device__ __forceinline__ float fadd_s(float a,float b){float r;asm("v_add_f32_e32 %0, %1, %2":"=v"(r):"v"(a),"v"(b));return r;}
__device__ __forceinline__ float fsub_s(float a,float b){float r;asm("v_sub_f32_e32 %0, %1, %2":"=v"(r):"v"(a),"v"(b));return r;}
typedef float f32x2_t __attribute__((ext_vector_type(2))); typedef __bf16 bf16x2_t __attribute__((ext_vector_type(2)));
__device__ __forceinline__ unsigned cvtpk_s(float lo,float hi){f32x2_t v={lo,hi};bf16x2_t b=__builtin_convertvector(v,bf16x2_t);return __builtin_bit_cast(unsigned,b);}
#define WAIT_BAR(N) asm volatile("s_waitcnt vmcnt(" #N ") lgkmcnt(0)\n\ts_barrier":::"memory")

__device__ __forceinline__ void qkt(f32x16&p0,f32x16&p1,const char*Kslot,const bf16x8*qr,const f32x16&negm,int r32,int hi){
  const char*kb=Kslot+hi*1024+r32*16;
  #pragma unroll
  for(int d0=0;d0<4;++d0){
    const bf16x8 b0=*reinterpret_cast<const bf16x8*>(kb+d0*2048);
    const bf16x8 b1=*reinterpret_cast<const bf16x8*>(kb+d0*2048+512);
    if(d0==0){p0=__builtin_amdgcn_mfma_f32_32x32x16_bf16(b0,qr[0],negm,0,0,0);p1=__builtin_amdgcn_mfma_f32_32x32x16_bf16(b1,qr[0],negm,0,0,0);}
    else{p0=__builtin_amdgcn_mfma_f32_32x32x16_bf16(b0,qr[d0],p0,0,0,0);p1=__builtin_amdgcn_mfma_f32_32x32x16_bf16(b1,qr[d0],p1,0,0,0);}}
}
typedef __attribute__((address_space(3))) const char* lds_cptr;
typedef short v4i16_t __attribute__((ext_vector_type(4)));
__device__ __forceinline__ void kload8(bf16x8*kf,lds_cptr kp){
  kf[0]=*(const __attribute__((address_space(3))) bf16x8*)(kp);      kf[1]=*(const __attribute__((address_space(3))) bf16x8*)(kp+512);
  kf[2]=*(const __attribute__((address_space(3))) bf16x8*)(kp+2048); kf[3]=*(const __attribute__((address_space(3))) bf16x8*)(kp+2560);
  kf[4]=*(const __attribute__((address_space(3))) bf16x8*)(kp+4096); kf[5]=*(const __attribute__((address_space(3))) bf16x8*)(kp+4608);
  kf[6]=*(const __attribute__((address_space(3))) bf16x8*)(kp+6144); kf[7]=*(const __attribute__((address_space(3))) bf16x8*)(kp+6656);
}
__device__ __forceinline__ void kload2(bf16x8*kf,lds_cptr kp,int j){ kf[2*j]=*(const __attribute__((address_space(3))) bf16x8*)(kp+j*2048); kf[2*j+1]=*(const __attribute__((address_space(3))) bf16x8*)(kp+j*2048+512); }
__device__ __forceinline__ s16x4 vtr(lds_cptr p){ return __builtin_bit_cast(s16x4,__builtin_amdgcn_ds_read_tr16_b64_v4i16((__attribute__((address_space(3))) v4i16_t*)p)); }
__device__ __forceinline__ float rowmax(const f32x16&p0,const f32x16&p1){
  float a=max3f(p0[0],p0[1],p1[0]),b=max3f(p0[2],p0[3],p1[1]);a=max3f(a,p1[2],p1[3]);
  #pragma unroll
  for(int r=4;r<16;r+=4){a=max3f(a,p0[r],p0[r+1]);b=max3f(b,p0[r+2],p0[r+3]);a=max3f(a,p1[r],p1[r+1]);b=max3f(b,p1[r+2],p1[r+3]);}
  const float m=max2f(a,b);
  auto rr=__builtin_amdgcn_permlane32_swap(__float_as_uint(m),__float_as_uint(m),false,false);
  return max2f(__uint_as_float(rr[0]),__uint_as_float(rr[1]));
}
__device__ __forceinline__ void pv(f32x16*o,int vb,bf16x8 pa0,bf16x8 pa1,bf16x8 pa2,bf16x8 pa3){
  #pragma unroll
  for(int d0=0;d0<2;++d0){s16x4 lo[4],hi[4];
    #pragma unroll
    for(int ks=0;ks<4;++ks){
      asm volatile("ds_read_b64_tr_b16 %0,%1 offset:%c2":"=&v"(lo[ks]):"v"(vb),"i"(d0*4096+ks*1024):"memory");
      asm volatile("ds_read_b64_tr_b16 %0,%1 offset:%c2":"=&v"(hi[ks]):"v"(vb),"i"(d0*4096+ks*1024+512):"memory");}
    asm volatile("s_waitcnt lgkmcnt(0)":::"memory");SBAR();
    #define PK(k) (bf16x8){lo[k][0],lo[k][1],lo[k][2],lo[k][3],hi[k][0],hi[k][1],hi[k][2],hi[k][3]}
    o[d0]=__builtin_amdgcn_mfma_f32_32x32x16_bf16(pa0,PK(0),o[d0],0,0,0);
    o[d0]=__builtin_amdgcn_mfma_f32_32x32x16_bf16(pa1,PK(1),o[d0],0,0,0);
    o[d0]=__builtin_amdgcn_mfma_f32_32x32x16_bf16(pa2,PK(2),o[d0],0,0,0);
    o[d0]=__builtin_amdgcn_mfma_f32_32x32x16_bf16(pa3,PK(3),o[d0],0,0,0);
    #undef PK
  }
}

#ifndef ATTN_STORE16
#define ATTN_STORE16(p,v) (*(u32x4*)(p)=(v))
#endif
template<int THRL> __device__ __forceinline__ void attn_unit(int qb,const bf16*Q,const bf16*__restrict__ K,const bf16*__restrict__ V,bf16*O,char*shm){
  int tid=threadIdx.x; asm volatile("":"+v"(tid)); const int lane=tid&63,r32=lane&31,hi=lane>>5; const int wid=__builtin_amdgcn_readfirstlane(tid>>6);
  const int q0=qb*QB;
  const bf16*Qw=Q+(long)(q0+wid*QBLK)*QP;
  const bf16*Kh=K,*Vh=V;
  const unsigned lds0=(unsigned)(uintptr_t)shm;
  float*wsf=(float*)(shm+LDS_WS)+wid*64;
  const bf16*ksrc=Kh+(long)lane*KP+wid*8;
  const bf16*vsrc=Vh+(long)(16*(wid&3)+(lane>>2))*KP+(wid>>2)*32+(lane&3)*8;
  const unsigned kdst=lds0+LDS_K+wid*1024, vdst=lds0+LDS_V+wid*1024;
  #define DMA_K(t,slot) glds16(ksrc+(long)(t)*KVBLK*KP,(unsigned)__builtin_amdgcn_readfirstlane(kdst+(slot)))
  #define DMA_V(t,slot) glds16(vsrc+(long)(t)*KVBLK*KP,(unsigned)__builtin_amdgcn_readfirstlane(vdst+(slot)))
  const int vb0=(int)(lds0+LDS_V)+((lane>>4)&1)*32+(lane&3)*8+(4*hi+((lane&15)>>2))*64;
  const char*Kbase=shm+LDS_K; bf16x8 kf[8];
  const lds_cptr shm3=(lds_cptr)shm; const lds_cptr kp0=shm3+LDS_K+hi*1024+r32*16; const lds_cptr vp0=shm3+LDS_V+((lane>>4)&1)*32+(lane&3)*8+(4*hi+((lane&15)>>2))*64;
  const int NT=NTILES;
  DMA_K(0,0);DMA_V(0,0);DMA_K(1,SLOTB);
  bf16x8 qr[4];
  #pragma unroll
  for(int d0=0;d0<4;++d0)qr[d0]=*reinterpret_cast<const bf16x8*>(&Qw[(long)r32*QP+d0*16+hi*8]);
  float mhat=0.f,l_reg=0.f;f32x16 o[2];o[0]=f32x16{};o[1]=f32x16{};f32x16 negm=f32x16{};asm volatile("":"+v"(negm));
  const int qrel=wid*QBLK+r32;
  #define CMASK(P0,P1,t) do{}while(0)
  bool resc=false;
  #define START(P0,P1) do{ const float rm=rowmax(P0,P1); resc=false; \
    { const float dl=rm; mhat=fadd_s(mhat,dl); \
      _Pragma("unroll") for(int r=0;r<16;++r){P0[r]=fsub_s(P0[r],dl);P1[r]=fsub_s(P1[r],dl);} \
      _Pragma("unroll") for(int r=0;r<16;++r)negm[r]=-mhat; asm volatile("":"+v"(negm)); } \
    _Pragma("unroll") for(int r=0;r<16;++r)P0[r]=__builtin_amdgcn_exp2f(P0[r]); }while(0)
  #define RESC() do{ if(resc){ asm volatile("s_waitcnt lgkmcnt(0)":::"memory"); \
      _Pragma("unroll") for(int d_=0;d_<2;++d_) _Pragma("unroll") for(int r=0;r<16;++r)o[d_][r]*=wsf[crow(r,hi)]; } }while(0)
  f32x16 pA0,pA1,pB0,pB1;
  int sl_prev=0,sl_cur=0,sl_next=SLOTB;
  #define ROT() do{sl_prev=sl_cur;sl_cur=sl_next;sl_next=(sl_next==(NSLOT-1)*SLOTB)?0:sl_next+SLOTB;}while(0)
  DMA_K(2,2*SLOTB);
  WAIT_BAR(3);
  qkt(pA0,pA1,Kbase,qr,negm,r32,hi);asm volatile("s_nop 15\n\ts_nop 7":"+v"(pA0),"+v"(pA1));CMASK(pA0,pA1,0);
  START(pA0,pA1);
  _Pragma("unroll") for(int r=0;r<16;++r)pA1[r]=__builtin_amdgcn_exp2f(pA1[r]);
  WAIT_BAR(0);
  DMA_K(3,0);DMA_V(1,SLOTB);
  ROT();
  kload8(kf,kp0+sl_cur);
  WAIT_BAR(2);
  s16x4 vlo[8],vhi[8]; u32x4 pw0,pw1,pw2,pw3;
  #define PKW(P,B) cvtpk_s(P[B],P[B+1])
  #define PAF(k) __builtin_bit_cast(bf16x8,pw##k)
  #define VFR(i) (bf16x8){vlo[i][0],vlo[i][1],vlo[i][2],vlo[i][3],vhi[i][0],vhi[i][1],vhi[i][2],vhi[i][3]}
  #define PIN(x) asm volatile("":"+v"(x))
  #define MX3(a,b,c) __builtin_fmaxf(__builtin_fmaxf((a),(b)),(c))
  #define GAPA(MF,A0,A1,A2,A3,W0,W1,PW) do{ MF; sacc+=A0; sacc+=A1; sacc+=A2; sacc+=A3; PIN(sacc); W0; W1; PIN(PW); SBAR(); }while(0)
  #define EX(v) __builtin_amdgcn_exp2f(v)
  #define GAPB(MF,X,B) do{ MF; X[B]=EX(X[B]); X[B+1]=EX(X[B+1]); X[B+2]=EX(X[B+2]); X[B+3]=EX(X[B+3]); PIN(X); SBAR(); }while(0)
  #define VRD(i) do{ vlo[i]=vtr(vp_+(((i)>>2)*4096+((i)&3)*1024)); vhi[i]=vtr(vp_+(((i)>>2)*4096+((i)&3)*1024+512)); }while(0)
  #define KRD(G,j) do{ if(G){ kload2(kf,kp0+sl_next,j); SBAR(); } }while(0)
  #define STEP(C0,C1,P0,P1,t,GK,GV,GL) do{ SBAR(); \
    const lds_cptr vp_=vp0+sl_prev; \
    VRD(0); SBAR(); float sacc=(P0[0]+P0[1]); \
    GAPA(C0=__builtin_amdgcn_mfma_f32_32x32x16_bf16(kf[0],qr[0],negm,0,0,0), P0[2],P0[3],P0[4],P0[5],     pw0[0]=PKW(P0,0), pw0[1]=PKW(P0,2), pw0); \
    VRD(4); SBAR(); GAPA(C1=__builtin_amdgcn_mfma_f32_32x32x16_bf16(kf[1],qr[0],negm,0,0,0), P0[6],P0[7],P0[8],P0[9],     pw0[2]=PKW(P0,4), pw0[3]=PKW(P0,6), pw0); \
    VRD(1); SBAR(); GAPA(C0=__builtin_amdgcn_mfma_f32_32x32x16_bf16(kf[2],qr[1],C0,0,0,0),   P0[10],P0[11],P0[12],P0[13], pw1[0]=PKW(P0,8), pw1[1]=PKW(P0,10), pw1); \
    VRD(5); SBAR(); GAPA(C1=__builtin_amdgcn_mfma_f32_32x32x16_bf16(kf[3],qr[1],C1,0,0,0),   P0[14],P0[15],P1[0],P1[1],   pw1[2]=PKW(P0,12),pw1[3]=PKW(P0,14), pw1); \
    VRD(2); SBAR(); GAPA(C0=__builtin_amdgcn_mfma_f32_32x32x16_bf16(kf[4],qr[2],C0,0,0,0),   P1[2],P1[3],P1[4],P1[5],     pw2[0]=PKW(P1,0), pw2[1]=PKW(P1,2), pw2); \
    VRD(6); SBAR(); GAPA(C1=__builtin_amdgcn_mfma_f32_32x32x16_bf16(kf[5],qr[2],C1,0,0,0),   P1[6],P1[7],P1[8],P1[9],     pw2[2]=PKW(P1,4), pw2[3]=PKW(P1,6), pw2); \
    VRD(3); SBAR(); GAPA(C0=__builtin_amdgcn_mfma_f32_32x32x16_bf16(kf[6],qr[3],C0,0,0,0),   P1[10],P1[11],P1[12],P1[13], pw3[0]=PKW(P1,8), pw3[1]=PKW(P1,10), pw3); \
    VRD(7); SBAR(); GAPA(C1=__builtin_amdgcn_mfma_f32_32x32x16_bf16(kf[7],qr[3],C1,0,0,0),   P1[14],P1[15],0.f,0.f,       pw3[2]=PKW(P1,12),pw3[3]=PKW(P1,14), pw3); \
    l_reg+=sacc; \
    if(GK){DMA_K((t)+3,sl_cur);} if(GV){DMA_V((t)+1,sl_next);} \
    CMASK(C0,C1,t); \
    { float a=MX3(C0[0],C0[1],C1[0]),b=MX3(C0[2],C0[3],C1[1]); a=MX3(a,C1[2],C1[3]); \
      _Pragma("unroll") for(int r=4;r<16;r+=4){a=MX3(a,C0[r],C0[r+1]);b=MX3(b,C0[r+2],C0[r+3]);a=MX3(a,C1[r],C1[r+1]);b=MX3(b,C1[r+2],C1[r+3]);} \
      float rm=__builtin_fmaxf(a,b); { auto rr=__builtin_amdgcn_permlane32_swap(__float_as_uint(rm),__float_as_uint(rm),false,false); rm=__builtin_fmaxf(__uint_as_float(rr[0]),__uint_as_float(rr[1])); } \
      resc=false; \
      if(__builtin_expect(__any(rm>(float)THRL),0)){ const float dl=__builtin_fmaxf(rm,0.f); mhat+=dl; \
        _Pragma("unroll") for(int r=0;r<16;++r){C0[r]-=dl;C1[r]-=dl;} \
        _Pragma("unroll") for(int r=0;r<16;++r)negm[r]=-mhat; asm volatile("":"+v"(negm)); \
        const float f=__builtin_amdgcn_exp2f(-dl); l_reg*=f; if(hi==0)wsf[r32]=f; resc=true; } } \
    SBAR(); \
    GAPB(o[0]=__builtin_amdgcn_mfma_f32_32x32x16_bf16(PAF(0),VFR(0),o[0],0,0,0), C0,0); \
    GAPB(o[1]=__builtin_amdgcn_mfma_f32_32x32x16_bf16(PAF(0),VFR(4),o[1],0,0,0), C0,4); \
    KRD(GL,0); GAPB(o[0]=__builtin_amdgcn_mfma_f32_32x32x16_bf16(PAF(1),VFR(1),o[0],0,0,0), C0,8); \
    KRD(GL,1); GAPB(o[1]=__builtin_amdgcn_mfma_f32_32x32x16_bf16(PAF(1),VFR(5),o[1],0,0,0), C0,12); \
    KRD(GL,2); GAPB(o[0]=__builtin_amdgcn_mfma_f32_32x32x16_bf16(PAF(2),VFR(2),o[0],0,0,0), C1,0); \
    KRD(GL,3); GAPB(o[1]=__builtin_amdgcn_mfma_f32_32x32x16_bf16(PAF(2),VFR(6),o[1],0,0,0), C1,4); \
    GAPB(o[0]=__builtin_amdgcn_mfma_f32_32x32x16_bf16(PAF(3),VFR(3),o[0],0,0,0), C1,8); \
    GAPB(o[1]=__builtin_amdgcn_mfma_f32_32x32x16_bf16(PAF(3),VFR(7),o[1],0,0,0), C1,12); \
    }while(0)
  int t=1;
  #undef CMASK
  #define CMASK(P0,P1,t) do{}while(0)
  for(;t+5<NT;t+=2){
    STEP(pB0,pB1,pA0,pA1,t,true,true,true);     WAIT_BAR(2); RESC(); ROT();
    STEP(pA0,pA1,pB0,pB1,t+1,true,true,true);   WAIT_BAR(2); RESC(); ROT();
  }
  #undef CMASK
  #define CMASK(P0,P1,t) do{}while(0)
  #define ENDW(tt) do{ if((tt)+3<NT){WAIT_BAR(2);} else if((tt)+2<NT){WAIT_BAR(1);} else {WAIT_BAR(0);} }while(0)
  for(;t+1<NT;t+=2){
    STEP(pB0,pB1,pA0,pA1,t,(t+3<NT),(t+1<NT),(t+1<NT));       ENDW(t);   RESC(); ROT();
    STEP(pA0,pA1,pB0,pB1,t+1,(t+4<NT),(t+2<NT),(t+2<NT));     ENDW(t+1); RESC(); ROT();
  }
  STEP(pB0,pB1,pA0,pA1,NT-1,false,false,false); RESC();
  { float sacc=pB0[0]+pB0[1]; _Pragma("unroll") for(int r=2;r<16;++r)sacc+=pB0[r]; _Pragma("unroll") for(int r=0;r<16;++r)sacc+=pB1[r]; l_reg+=sacc;
    pw0=(u32x4){PKW(pB0,0),PKW(pB0,2),PKW(pB0,4),PKW(pB0,6)};pw1=(u32x4){PKW(pB0,8),PKW(pB0,10),PKW(pB0,12),PKW(pB0,14)};pw2=(u32x4){PKW(pB1,0),PKW(pB1,2),PKW(pB1,4),PKW(pB1,6)};pw3=(u32x4){PKW(pB1,8),PKW(pB1,10),PKW(pB1,12),PKW(pB1,14)};
    SBAR(); pv(o,vb0+sl_cur,PAF(0),PAF(1),PAF(2),PAF(3)); }
  #undef PKW
  #undef PAF
  #undef VFR
  #undef PIN
  #undef MX3
  #undef GAPA
  #undef GAPB
  #undef EX
  #undef VRD
  #undef KRD
  #undef STEP
  #undef ENDW
  {auto rr=__builtin_amdgcn_permlane32_swap(__float_as_uint(l_reg),__float_as_uint(l_reg),false,false);l_reg=__uint_as_float(rr[0])+__uint_as_float(rr[1]);}
  if(hi==0)wsf[32+r32]=l_reg;asm volatile("s_waitcnt lgkmcnt(0)":::"memory");
  float rli[16];
  #pragma unroll
  for(int r=0;r<16;++r)rli[r]=__builtin_amdgcn_rcpf(wsf[32+crow(r,hi)]);
  bf16*Ow=O+(long)(q0+wid*QBLK)*OP;
  { bf16*stg=(bf16*)(shm+LDS_OST)+wid*2048;
    #pragma unroll
    for(int r=0;r<16;++r){const int orow=crow(r,hi);
      #pragma unroll
      for(int d0=0;d0<2;++d0)stg[orow*64+d0*32+r32]=__float2bfloat16(o[d0][r]*rli[r]);}
    asm volatile("s_waitcnt lgkmcnt(0)":::"memory");
    #pragma unroll
    for(int i=0;i<4;++i){const int row=i*8+(lane>>3),ch=lane&7; const u32x4 v=*(const u32x4*)(stg+row*64+ch*8); ATTN_STORE16(Ow+(long)row*OP+ch*8,v);} }
  asm volatile("s_waitcnt lgkmcnt(0)\n\ts_barrier":::"memory");
  #undef DMA_K
  #undef DMA_V
  #undef CMASK
  #undef START
  #undef RESC
  #undef ROT
}
constexpr int ATTN_LDS_BYTES=LDS_BYTES;
struct AttnTensors { const bf16* Q; const bf16* K; const bf16* V; bf16* O; };
struct AttnUnit { int bh; int qb; };
}
#define LAS __attribute__((address_space(3)))
typedef unsigned short bf16_t;
typedef short bf16x8 __attribute__((ext_vector_type(8)));
typedef short s16x4 __attribute__((ext_vector_type(4)));
typedef float f32x4 __attribute__((ext_vector_type(4)));
typedef float f32x16 __attribute__((ext_vector_type(16)));
typedef unsigned u32x4 __attribute__((ext_vector_type(4)));
typedef unsigned u32x2 __attribute__((ext_vector_type(2)));

constexpr int S_LAT = 16384, N_CTX = 256, MT = 16640, DM = 1024, N_EVEN = 2304, N_ODD = 1280, FF = 2816, NU = 5632, NMOD = 6144;
constexpr float DN_ALPHA = 1.6817928305074290f, LOG2E = 1.4426950408889634f, QC2 = 0.125f * 1.4426950408889634f, LN_EPS = 1e-5f;
constexpr size_t MiB = 1u << 20;
constexpr size_t WS_MODS = 0, WS_ROPE = 256 * 1024, WS_WIN = 1 * MiB, WS_WOUT = 6 * MiB, WS_WUP = 8 * MiB, WS_WDN = 19 * MiB, WS_XS = 25 * MiB, WS_R1 = 90 * MiB, WS_O = WS_R1 + 74 * MiB,
                 WS_HF = 269 * MiB, WS_XN = WS_HF + 1 * MiB, WS_END = 359 * MiB;
static_assert((size_t)MT * N_EVEN * 2 <= 74 * MiB && WS_R1 + (size_t)MT * NU * 2 <= WS_HF && WS_HF + (size_t)MT * FF * 2 <= WS_END && (size_t)(MT + 512) * DM * 2 + MiB <= (size_t)MT * FF * 2, "ws map");
constexpr int LDS_BYTES = 147456;

struct Args { const float* in[20]; float* out; unsigned char* ws; };
typedef const __attribute__((address_space(4))) Args* ArgsP;
__device__ __forceinline__ ArgsP relaunder(ArgsP p) { asm volatile("" : "+s"(p)); return p; }

__device__ __forceinline__ unsigned pk2(float lo, float hi) { return pg8::pk_bf16(lo, hi); }
__device__ __forceinline__ float bf_lo(unsigned w) { return __uint_as_float(w << 16); }
__device__ __forceinline__ float bf_hi(unsigned w) { return __uint_as_float(w & 0xffff0000u); }
__device__ __forceinline__ float wave_sum(float v) {
#pragma unroll
    for (int o = 1; o < 64; o <<= 1) v += __shfl_xor(v, o);
    return v;
}
__device__ __forceinline__ float silu_f(float v) { return v / (1.0f + __expf(-v)); }

template <int KIND> __device__ __forceinline__ int cmap(int cp) {
    if (KIND == 0) return cp;
    if (KIND == 3) { const int pn = cp >> 8, bj = (cp >> 7) & 1, x = cp & 127; return FF * bj + 128 * pn + x; }
    const int pn = cp >> 8, bj = (cp >> 7) & 1, wc = (cp >> 5) & 3, p = cp & 31, hb = 256 * pn + 64 * wc;
    const bool rope = hb < (KIND == 1 ? 640 : 1152);
    const int d32 = rope ? (16 * ((p >> 2) & 1) + 4 * (p >> 3) + (p & 3)) : p;
    return hb + 32 * bj + d32;
}
template <int KIND> __device__ __forceinline__ void transpose_item(const float* W, int K, int N, bf16_t* WT, LAS float* scr, int item, int lane) {
    const int nblk = N / 32, kb = item / nblk, nb = item % nblk, k0 = 64 * kb, n0 = 32 * nb;
    const int o0 = cmap<KIND>(n0) & ~31;
#pragma unroll 8
    for (int i = 0; i < 32; ++i) { const int kk = 2 * i + (lane >> 5); scr[kk * 33 + (lane & 31)] = W[(size_t)(k0 + kk) * N + o0 + (lane & 31)]; }
    asm volatile("s_waitcnt lgkmcnt(0)" ::: "memory");
    const int c = lane & 7;
#pragma unroll
    for (int j = 0; j < 4; ++j) { const int n = (lane >> 3) + 8 * j; const int sidx = cmap<KIND>(n0 + n) - o0; const LAS float* s = scr + (8 * c) * 33 + sidx;
        u32x4 o; o.x = pk2(s[0 * 33], s[1 * 33]); o.y = pk2(s[2 * 33], s[3 * 33]); o.z = pk2(s[4 * 33], s[5 * 33]); o.w = pk2(s[6 * 33], s[7 * 33]);
        *(u32x4*)(WT + (size_t)(n0 + n) * K + k0 + 8 * c) = o; }
    asm volatile("s_waitcnt lgkmcnt(0)" ::: "memory");
}
__device__ __forceinline__ void convert_layer(ArgsP a, int l, LAS unsigned char* lds, int gw, int ngw, int wave, int lane) {
    LAS float* scr = (LAS float*)(lds + wave * 16384);
    unsigned char* ws = a->ws;
    const int i = l >> 1; const bool odd = l & 1;
    const int n_in = odd ? N_ODD : N_EVEN;
    const float* w_in = odd ? a->in[13] + (size_t)i * DM * N_ODD : a->in[8] + (size_t)i * DM * N_EVEN;
    const float* w_out = (odd ? a->in[14] : a->in[9]) + (size_t)i * DM * DM;
    const float* w_up = a->in[16] + (size_t)l * DM * NU;
    const float* w_dn = a->in[19] + (size_t)l * FF * DM;
    const int I_IN = (DM / 64) * (n_in / 32), I_OUT = (DM / 64) * (DM / 32), I_UP = (DM / 64) * (NU / 32), I_DN = (FF / 64) * (DM / 32);
    const int total = I_IN + I_OUT + I_UP + I_DN;
    for (int it = gw; it < total; it += ngw) {
        int r = it;
        if (r < I_IN) { if (odd) transpose_item<2>(w_in, DM, n_in, (bf16_t*)(ws + WS_WIN), scr, r, lane); else transpose_item<1>(w_in, DM, n_in, (bf16_t*)(ws + WS_WIN), scr, r, lane); continue; } r -= I_IN;
        if (r < I_OUT) { transpose_item<0>(w_out, DM, DM, (bf16_t*)(ws + WS_WOUT), scr, r, lane); continue; } r -= I_OUT;
        if (r < I_UP) { transpose_item<3>(w_up, DM, NU, (bf16_t*)(ws + WS_WUP), scr, r, lane); continue; } r -= I_UP;
        transpose_item<0>(w_dn, FF, DM, (bf16_t*)(ws + WS_WDN), scr, r, lane);
    }
}

__device__ __forceinline__ void phase_adaln(ArgsP a, LAS unsigned char* lds, int bid, int G, int tid, int wave, int lane) {
    LAS float* red = (LAS float*)(lds + 8 * 16384);
    const float* c = a->in[1]; const float* cc = a->in[3]; const float* ada_w = a->in[4]; const float* ada_b = a->in[5];
    float* mods = (float*)(a->ws + WS_MODS);
    for (int task = bid; task < 96; task += G) {
        const int l = task / 24, cgp = task % 24;
        const float* W = ada_w + (size_t)l * DM * NMOD + cgp * 256 + 4 * lane;
        f32x4 a0 = {0.f, 0.f, 0.f, 0.f}, a1 = {0.f, 0.f, 0.f, 0.f};
#pragma unroll 8
        for (int kk = 0; kk < 128; ++kk) { const int k = wave * 128 + kk; const float s0 = silu_f(c[k]), s1 = silu_f(cc[k]);
            const f32x4 w = *(const f32x4*)(W + (size_t)k * NMOD); a0 += w * s0; a1 += w * s1; }
#pragma unroll
        for (int j = 0; j < 4; ++j) { red[(wave * 2 + 0) * 256 + 4 * lane + j] = a0[j]; red[(wave * 2 + 1) * 256 + 4 * lane + j] = a1[j]; }
        __syncthreads();
        { const int v = tid >> 8, col = tid & 255; float s = 0.f;
#pragma unroll
          for (int w = 0; w < 8; ++w) s += red[(w * 2 + v) * 256 + col];
          mods[(size_t)(l * 2 + v) * NMOD + cgp * 256 + col] = s + ada_b[l * NMOD + cgp * 256 + col]; }
        __syncthreads();
    }
}
__device__ __forceinline__ void rope_tables(ArgsP a, int tid) {
    float* cosT = (float*)(a->ws + WS_ROPE); float* sinT = cosT + 4096;
    for (int idx = tid; idx < 4096; idx += 512) { const int pos = idx >> 4, i = idx & 15;
        const float f = exp2f(-(float)i * (13.287712379549449f / 16.0f)); const float ang = (float)pos * f;
        cosT[idx] = __cosf(ang); sinT[idx] = __sinf(ang); }
}
__device__ __forceinline__ void phase_init(ArgsP a, int gw, int ngw, int lane) {
    float* XS = (float*)(a->ws + WS_XS); bf16_t* XN = (bf16_t*)(a->ws + WS_XN); const float* mods = (const float*)(a->ws + WS_MODS);
    for (int r = gw; r < MT; r += ngw) {
        const bool isc = r >= S_LAT; const float* src = isc ? a->in[2] + (size_t)(r - S_LAT) * DM : a->in[0] + (size_t)r * DM;
        const float* mv = mods + (isc ? NMOD : 0);
#pragma unroll
        for (int j = 0; j < 4; ++j) { const int c0 = 4 * lane + 256 * j; const f32x4 x = *(const f32x4*)(src + c0), sh = *(const f32x4*)(mv + c0), sc = *(const f32x4*)(mv + DM + c0);
            *(f32x4*)(XS + (size_t)r * DM + c0) = x; const f32x4 h = x * (sc + 1.0f) + sh;
            u32x2 w; w.x = pk2(h[0], h[1]); w.y = pk2(h[2], h[3]); *(u32x2*)(XN + (size_t)r * DM + c0) = w; }
    }
}
__device__ __forceinline__ void phase_ln(ArgsP a, int nrows, const float* g, const float* b, const float* mod_lat  , float* dout, int gw, int ngw, int lane) {
    float* XS = (float*)(a->ws + WS_XS); bf16_t* XN = (bf16_t*)(a->ws + WS_XN);
    for (int r = gw; r < nrows; r += ngw) {
        const float* zr = XS + (size_t)r * DM;
        f32x4 v[4]; float s = 0.f;
#pragma unroll
        for (int j = 0; j < 4; ++j) { v[j] = *(const f32x4*)(zr + 4 * lane + 256 * j); s += (v[j][0] + v[j][1]) + (v[j][2] + v[j][3]); }
        const float mean = wave_sum(s) * (1.0f / DM); float s2 = 0.f;
#pragma unroll
        for (int j = 0; j < 4; ++j) { v[j] = v[j] - mean; s2 += (v[j][0] * v[j][0] + v[j][1] * v[j][1]) + (v[j][2] * v[j][2] + v[j][3] * v[j][3]); }
        const float rstd = 1.0f / sqrtf(wave_sum(s2) * (1.0f / DM) + LN_EPS);
        const float* mv = mod_lat ? mod_lat + (r >= S_LAT ? NMOD : 0) : nullptr;
#pragma unroll
        for (int j = 0; j < 4; ++j) { const int c0 = 4 * lane + 256 * j; const f32x4 x = v[j] * rstd * *(const f32x4*)(g + c0) + *(const f32x4*)(b + c0);
            if (dout) *(f32x4*)(dout + (size_t)r * DM + c0) = x;
            else { *(f32x4*)(XS + (size_t)r * DM + c0) = x;
                const f32x4 h = x * (*(const f32x4*)(mv + DM + c0) + 1.0f) + *(const f32x4*)(mv + c0);
                u32x2 w; w.x = pk2(h[0], h[1]); w.y = pk2(h[2], h[3]); *(u32x2*)(XN + (size_t)r * DM + c0) = w; } }
    }
}
__device__ __forceinline__ void unpack8(const u32x4 w, float (&f)[8]) { f[0] = bf_lo(w.x); f[1] = bf_hi(w.x); f[2] = bf_lo(w.y); f[3] = bf_hi(w.y); f[4] = bf_lo(w.z); f[5] = bf_hi(w.z); f[6] = bf_lo(w.w); f[7] = bf_hi(w.w); }
__device__ __forceinline__ void phase_conv(ArgsP a, int l, int nrows, int gtid, int ngt) {
    const bf16_t* U = (const bf16_t*)(a->ws + WS_R1); bf16_t* HF = (bf16_t*)(a->ws + WS_HF);
    const float* cw = a->in[17] + (size_t)l * 3 * NU; const float* cb = a->in[18] + (size_t)l * NU;
    const int nitems = (nrows / 8) * 352;
    for (int idx = gtid; idx < nitems; idx += ngt) {
        const int chunk = idx % 352, rb = idx / 352, row0 = rb * 8, c = chunk * 8;
        const int seg_lo = row0 < S_LAT ? 0 : S_LAT, seg_hi = row0 < S_LAT ? S_LAT : MT;
        const int ucol = 256 * (c >> 7) + (c & 127);
        float wa[3][8], wg[3][8], ba[8], bg[8];
#pragma unroll
        for (int j = 0; j < 3; ++j) {
#pragma unroll
            for (int e = 0; e < 8; e += 4) { const f32x4 x = *(const f32x4*)(cw + j * NU + c + e), y = *(const f32x4*)(cw + j * NU + FF + c + e);
                wa[j][e] = x[0]; wa[j][e + 1] = x[1]; wa[j][e + 2] = x[2]; wa[j][e + 3] = x[3]; wg[j][e] = y[0]; wg[j][e + 1] = y[1]; wg[j][e + 2] = y[2]; wg[j][e + 3] = y[3]; } }
#pragma unroll
        for (int e = 0; e < 8; e += 4) { const f32x4 x = *(const f32x4*)(cb + c + e), y = *(const f32x4*)(cb + FF + c + e);
            ba[e] = x[0]; ba[e + 1] = x[1]; ba[e + 2] = x[2]; ba[e + 3] = x[3]; bg[e] = y[0]; bg[e + 1] = y[1]; bg[e + 2] = y[2]; bg[e + 3] = y[3]; }
        const u32x4 zero = {0u, 0u, 0u, 0u};
        const bf16_t* up = U + (size_t)row0 * NU + ucol;
        u32x4 pa = zero, pg = zero, ca, cg_, na, ng;
        if (row0 - 1 >= seg_lo) { pa = *(const u32x4*)(up - NU); pg = *(const u32x4*)(up - NU + 128); }
        ca = *(const u32x4*)(up); cg_ = *(const u32x4*)(up + 128);
#pragma unroll
        for (int i = 0; i < 8; ++i) {
            const int row = row0 + i;
            if (row + 1 < seg_hi) { na = *(const u32x4*)(up + (size_t)(i + 1) * NU); ng = *(const u32x4*)(up + (size_t)(i + 1) * NU + 128); } else { na = zero; ng = zero; }
            float fpa[8], fca[8], fna[8], fpg[8], fcg[8], fng[8], h[8];
            unpack8(pa, fpa); unpack8(ca, fca); unpack8(na, fna); unpack8(pg, fpg); unpack8(cg_, fcg); unpack8(ng, fng);
#pragma unroll
            for (int e = 0; e < 8; ++e) { const float av = ba[e] + wa[0][e] * fpa[e] + wa[1][e] * fca[e] + wa[2][e] * fna[e]; const float gv = bg[e] + wg[0][e] * fpg[e] + wg[1][e] * fcg[e] + wg[2][e] * fng[e];
                h[e] = silu_f(gv) * av; }
            u32x4 o; o.x = pk2(h[0], h[1]); o.y = pk2(h[2], h[3]); o.z = pk2(h[4], h[5]); o.w = pk2(h[6], h[7]);
            *(u32x4*)(HF + (size_t)row * FF + c) = o;
            pa = ca; pg = cg_; ca = na; cg_ = ng;
        }
    }
}

typedef short v4i16_t __attribute__((ext_vector_type(4)));
template <int MODE>
__device__ __forceinline__ void wave_attn(const bf16_t* Q, const bf16_t* K, const bf16_t* V, bf16_t* O, int pitch, int qtok, int nloc, int kbase, int kstride,
                                          const LAS float* rpb, bool has_sink, float sink_l2, LAS unsigned char* vl, int lane) {
    const int r32 = lane & 31, hi = lane >> 5;
    bf16x8 qr[4];
    { const bf16_t* qp = Q + (size_t)qtok * pitch + 8 * hi;
#pragma unroll
      for (int d0 = 0; d0 < 4; ++d0) qr[d0] = *(const bf16x8*)(qp + 16 * d0); }
    float m = -1e30f, l = 0.f;
    f32x16 o0, o1;
#pragma unroll
    for (int r = 0; r < 16; ++r) { o0[r] = 0.f; o1[r] = 0.f; }
    const int ntile = nloc + 8;
    const int qrow = qtok >> 6, qcol = qtok & 63;
    const int rs_q = min(max(qrow - 4, 0), 248), cs_q = min(max(qcol - 8, 0), 48);
    bf16x8 kfn[4], vn[4];
    { const int kt = nloc > 0 ? kbase : S_LAT;
      const bf16_t* kp = K + (size_t)(kt + r32) * pitch + 8 * hi; const bf16_t* vp = V + (size_t)(kt + (lane >> 1)) * pitch + (lane & 1) * 32;
#pragma unroll
      for (int d0 = 0; d0 < 4; ++d0) { kfn[d0] = *(const bf16x8*)(kp + 16 * d0); vn[d0] = *(const bf16x8*)(vp + 8 * d0); } }
    const LAS unsigned char* vb = vl + (4 * hi + ((lane & 15) >> 2)) * 144 + ((lane >> 4) & 1) * 32 + (lane & 3) * 8;
    LAS unsigned char* vdst = vl + (lane >> 1) * 144 + (lane & 1) * 64;
    for (int u = 0; u < ntile; ++u) {
        bf16x8 kf[4], vr[4];
#pragma unroll
        for (int d0 = 0; d0 < 4; ++d0) { kf[d0] = kfn[d0]; vr[d0] = vn[d0]; }
        if (u + 1 < ntile) {
            const int kt = (u + 1 < nloc) ? kbase + kstride * (u + 1) : S_LAT + 32 * (u + 1 - nloc);
            const bf16_t* kp = K + (size_t)(kt + r32) * pitch + 8 * hi; const bf16_t* vp = V + (size_t)(kt + (lane >> 1)) * pitch + (lane & 1) * 32;
#pragma unroll
            for (int d0 = 0; d0 < 4; ++d0) { kfn[d0] = *(const bf16x8*)(kp + 16 * d0); vn[d0] = *(const bf16x8*)(vp + 8 * d0); }
        }
        asm volatile("" ::: "memory");
#pragma unroll
        for (int d0 = 0; d0 < 4; ++d0) *(LAS bf16x8*)(vdst + 16 * d0) = vr[d0];
        f32x16 s;
#pragma unroll
        for (int r = 0; r < 16; ++r) s[r] = 0.f;
#pragma unroll
        for (int d0 = 0; d0 < 4; ++d0) s = __builtin_amdgcn_mfma_f32_32x32x16_bf16(kf[d0], qr[d0], s, 0, 0, 0);
        if (MODE != 2 && u < nloc) {
            if (MODE == 0) {
                const int kr = (kbase >> 6) + u, c0 = kbase & 63;
                const bool rowok = (kr >= rs_q) && (kr < rs_q + 8);
                const int ib = (kr - qrow + 7) * 31 + (c0 - qcol + 15);
#pragma unroll
                for (int r = 0; r < 16; ++r) { const int kvl = (r & 3) + 8 * (r >> 2) + 4 * hi; const int kc = c0 + kvl;
                    const bool ok = rowok && (kc >= cs_q) && (kc < cs_q + 16);
                    const float bias = rpb[ok ? ib + kvl : 0];
                    s[r] = ok ? s[r] + bias : -1e30f; }
            } else {
                const int d0k = kbase + kstride * u - qtok;
#pragma unroll
                for (int r = 0; r < 16; ++r) { const int dd = d0k + (r & 3) + 8 * (r >> 2) + 4 * hi; s[r] = (dd >= -128 && dd <= 128) ? s[r] : -1e30f; }
            }
        }
        float tm = s[0];
#pragma unroll
        for (int r = 1; r < 16; ++r) tm = fmaxf(tm, s[r]);
        tm = fmaxf(tm, __shfl_xor(tm, 32));
        const float mn = fmaxf(m, tm), al = __builtin_amdgcn_exp2f(m - mn); m = mn;
        float rsum = 0.f;
#pragma unroll
        for (int r = 0; r < 16; ++r) { s[r] = __builtin_amdgcn_exp2f(s[r] - mn); rsum += s[r]; }
        l = l * al + rsum;
#pragma unroll
        for (int r = 0; r < 16; ++r) { o0[r] *= al; o1[r] *= al; }
        u32x4 w0, w1;
        w0.x = pk2(s[0], s[1]); w0.y = pk2(s[2], s[3]); w0.z = pk2(s[4], s[5]); w0.w = pk2(s[6], s[7]);
        w1.x = pk2(s[8], s[9]); w1.y = pk2(s[10], s[11]); w1.z = pk2(s[12], s[13]); w1.w = pk2(s[14], s[15]);
        const bf16x8 pf0 = __builtin_bit_cast(bf16x8, w0), pf1 = __builtin_bit_cast(bf16x8, w1);
        asm volatile("s_waitcnt lgkmcnt(0)" ::: "memory");
#pragma unroll
        for (int s2 = 0; s2 < 2; ++s2) {
#pragma unroll
            for (int d0 = 0; d0 < 2; ++d0) {
                const s16x4 lo = __builtin_bit_cast(s16x4, __builtin_amdgcn_ds_read_tr16_b64_v4i16((LAS v4i16_t*)(vb + (16 * s2) * 144 + d0 * 64)));
                const s16x4 hh = __builtin_bit_cast(s16x4, __builtin_amdgcn_ds_read_tr16_b64_v4i16((LAS v4i16_t*)(vb + (16 * s2 + 8) * 144 + d0 * 64)));
                const bf16x8 vf = {lo[0], lo[1], lo[2], lo[3], hh[0], hh[1], hh[2], hh[3]};
                if (d0 == 0) o0 = __builtin_amdgcn_mfma_f32_32x32x16_bf16(vf, s2 ? pf1 : pf0, o0, 0, 0, 0);
                else         o1 = __builtin_amdgcn_mfma_f32_32x32x16_bf16(vf, s2 ? pf1 : pf0, o1, 0, 0, 0);
            }
        }
        asm volatile("s_waitcnt lgkmcnt(0)" ::: "memory");
    }
    if (has_sink) { const float mn = fmaxf(m, sink_l2), al = __builtin_amdgcn_exp2f(m - mn); l = l * al + (hi == 0 ? __builtin_amdgcn_exp2f(sink_l2 - mn) : 0.f);
#pragma unroll
        for (int r = 0; r < 16; ++r) { o0[r] *= al; o1[r] *= al; } }
    l += __shfl_xor(l, 32);
    const float inv = 1.0f / l;
    bf16_t* op = O + (size_t)qtok * DM + 4 * hi;
#pragma unroll
    for (int g = 0; g < 4; ++g) {
        u32x2 wa, wb; wa.x = pk2(o0[4 * g] * inv, o0[4 * g + 1] * inv); wa.y = pk2(o0[4 * g + 2] * inv, o0[4 * g + 3] * inv);
        wb.x = pk2(o1[4 * g] * inv, o1[4 * g + 1] * inv); wb.y = pk2(o1[4 * g + 2] * inv, o1[4 * g + 3] * inv);
        *(u32x2*)(op + 8 * g) = wa; *(u32x2*)(op + 32 + 8 * g) = wb;
    }
}
__device__ __forceinline__ void phase_attn_waves(ArgsP a, int l, bool ctx_out, LAS unsigned char* lds, int gw, int ngw, int wave, int lane) {
    const bool odd = l & 1; const int li = l >> 1;
    const bf16_t* QKV = (const bf16_t*)(a->ws + WS_R1); bf16_t* OB = (bf16_t*)(a->ws + WS_O);
    const LAS float* rpbL = (const LAS float*)lds;
    LAS unsigned char* vl = lds + 16384 + wave * 4608;
    const int r32 = lane & 31;
    const int nmain = odd ? 8192 : 4096, total = nmain + (ctx_out ? 128 : 0);
    for (int idx = gw; idx < total; idx += ngw) {
        if (idx < nmain) {
            const int h = idx >> 9, qt = idx & 511;
            if (!odd) {
                const int rp = qt >> 2, cb = qt & 3;
                const int R0 = min(max(2 * rp - 4, 0), 247), C0 = min(max(16 * cb - 8, 0), 32);
                const int qtok = (2 * rp + (r32 >> 4)) * 64 + 16 * cb + (r32 & 15);
                wave_attn<0>(QKV + 768 + h * 64, QKV + 1280 + h * 64, QKV + 1792 + h * 64, OB + 512 + h * 64, N_EVEN, qtok, 9, R0 * 64 + C0, 64, rpbL + h * 465, false, 0.f, vl, lane);
            } else {
                const int ulo = max(0, 4 - qt), uhi = min(8, 515 - qt);
                const float sk = a->in[15][li * 16 + h] * LOG2E;
                wave_attn<1>(QKV + h * 64, QKV + 1024 + (h >> 3) * 64, QKV + 1152 + (h >> 3) * 64, OB + h * 64, N_ODD, 32 * qt + r32, uhi - ulo + 1, 32 * qt - 128 + 32 * ulo, 32, rpbL, true, sk, vl, lane);
            }
        } else {
            const int j = idx - nmain, h = (j >> 3) & (odd ? 15 : 7), qt = j & 7; const int qtok = S_LAT + 32 * qt + r32;
            const bf16_t *q, *k, *v; bf16_t* o; bool sink = false; float sk = 0.f;
            if (odd) { q = QKV + h * 64; k = QKV + 1024 + (h >> 3) * 64; v = QKV + 1152 + (h >> 3) * 64; o = OB + h * 64; sink = true; sk = a->in[15][li * 16 + h] * LOG2E; }
            else if (j < 64) { q = QKV + h * 64; k = QKV + 512 + (h >> 2) * 64; v = QKV + 640 + (h >> 2) * 64; o = OB + h * 64; }
            else { q = QKV + 768 + h * 64; k = QKV + 1280 + h * 64; v = QKV + 1792 + h * 64; o = OB + 512 + h * 64; }
            wave_attn<2>(q, k, v, o, odd ? N_ODD : N_EVEN, qtok, 0, 0, 0, rpbL, sink, sk, vl, lane);
        }
    }
}

#define FRESH_IDS() int tid = threadIdx.x; asm volatile("" : "+v"(tid)); const int lane = tid & 63, wave = __builtin_amdgcn_readfirstlane(tid >> 6); const int gw = bid * 8 + wave, ngw = G * 8; (void)lane; (void)gw; (void)ngw
template <int L> __device__ __forceinline__ void run_layer(ArgsP ap, unsigned char* lds_raw, float* dout_unused) {
    constexpr int l = L; constexpr bool odd = (L & 1) != 0, ctx_out = L < 3; constexpr int li = L >> 1;
    constexpr int n_in = odd ? N_ODD : N_EVEN, m_rows = ctx_out ? MT : S_LAT;
    cg::grid_group grid = cg::this_grid();
    LAS unsigned char* lds = (LAS unsigned char*)lds_raw;
    const int G = gridDim.x, bid = blockIdx.x;
    {
        ArgsP a = relaunder(ap); unsigned char* ws = a->ws; const float* cosT = (const float*)(ws + WS_ROPE);
        pg8::Gemm g{(const bf16_t*)(ws + WS_XN), (const bf16_t*)(ws + WS_WIN), MT, n_in, DM}; pg8::StaticOrder S; S.init(MT, n_in, G, bid);
        pg8::EpiInproj E{(bf16_t*)(ws + WS_R1), n_in, a->in[10] + li * 64, a->in[11] + li * 64, cosT, cosT + 4096, odd ? 0 : 512, odd ? 0 : 640, odd ? 1152 : 640, odd ? 1024 : 512, odd ? 0 : 768, odd ? 0 : 1280, QC2};
        pg8::gemm_phase<pg8::EpiInproj, pg8::StaticOrder, true, true>(lds, g, S, E);
    }
    grid.sync();
    if (!odd) {
        FRESH_IDS(); ArgsP a = relaunder(ap); unsigned char* ws = a->ws; const bf16_t* QKV = (const bf16_t*)(ws + WS_R1); bf16_t* OB = (bf16_t*)(ws + WS_O);
        const int vcu = (G % 8 == 0) ? (bid % 8) * (G / 8) + bid / 8 : bid;
        for (int unit = vcu; unit < 512; unit += G) { const int h = unit >> 6, qb = unit & 63;
            attn_body::attn_unit<8>(qb, (const attn_body::bf16*)(QKV + h * 64), (const attn_body::bf16*)(QKV + 512 + (h >> 2) * 64), (const attn_body::bf16*)(QKV + 640 + (h >> 2) * 64),
                                    (attn_body::bf16*)(OB + h * 64), (char*)lds_raw); }
        __syncthreads();
        { const float* rpb = a->in[12] + (size_t)li * 8 * 465; LAS float* rl = (LAS float*)lds;
          for (int i = tid; i < 8 * 465; i += 512) rl[i] = rpb[i] * LOG2E; }
        __syncthreads();
    }
    { FRESH_IDS(); phase_attn_waves(relaunder(ap), l, ctx_out, lds, gw, ngw, wave, lane); }
    grid.sync();
    {
        ArgsP a = relaunder(ap); unsigned char* ws = a->ws; const float* ml = (const float*)(ws + WS_MODS) + (size_t)(l * 2) * NMOD;
        pg8::Gemm g{(const bf16_t*)(ws + WS_O), (const bf16_t*)(ws + WS_WOUT), m_rows, DM, DM}; pg8::StaticOrder S; S.init(m_rows, DM, G, bid);
        pg8::EpiResid E{(float*)(ws + WS_XS), ml + 2 * DM, ml + NMOD + 2 * DM, DN_ALPHA};
        pg8::gemm_phase<pg8::EpiResid, pg8::StaticOrder, true, true>(lds, g, S, E);
    }
    grid.sync();
    { FRESH_IDS(); ArgsP a = relaunder(ap); const float* ml = (const float*)(a->ws + WS_MODS) + (size_t)(l * 2) * NMOD;
      phase_ln(a, m_rows, a->in[6] + (size_t)(l * 2) * DM, a->in[7] + (size_t)(l * 2) * DM, ml + 3 * DM, nullptr, gw, ngw, lane); }
    grid.sync();
    {
        ArgsP a = relaunder(ap); unsigned char* ws = a->ws;
        pg8::Gemm g{(const bf16_t*)(ws + WS_XN), (const bf16_t*)(ws + WS_WUP), m_rows, NU, DM}; pg8::StaticOrder S; S.init(m_rows, NU, G, bid);
        pg8::EpiStore E{(bf16_t*)(ws + WS_R1), NU};
        pg8::gemm_phase<pg8::EpiStore, pg8::StaticOrder, true, true>(lds, g, S, E);
    }
    grid.sync();
    { FRESH_IDS(); phase_conv(relaunder(ap), l, m_rows, bid * 512 + tid, G * 512); }
    grid.sync();
    {
        ArgsP a = relaunder(ap); unsigned char* ws = a->ws; const float* ml = (const float*)(ws + WS_MODS) + (size_t)(l * 2) * NMOD;
        pg8::Gemm g{(const bf16_t*)(ws + WS_HF), (const bf16_t*)(ws + WS_WDN), m_rows, DM, FF}; pg8::StaticOrder S; S.init(m_rows, DM, G, bid);
        pg8::EpiResid E{(float*)(ws + WS_XS), ml + 5 * DM, ml + NMOD + 5 * DM, DN_ALPHA};
        pg8::gemm_phase<pg8::EpiResid, pg8::StaticOrder, true, true>(lds, g, S, E);
    }
    grid.sync();
    { FRESH_IDS(); ArgsP a = relaunder(ap);
      if (l < 3) { phase_ln(a, m_rows, a->in[6] + (size_t)(l * 2 + 1) * DM, a->in[7] + (size_t)(l * 2 + 1) * DM, (const float*)(a->ws + WS_MODS) + (size_t)((l + 1) * 2) * NMOD, nullptr, gw, ngw, lane);
                   convert_layer(relaunder(ap), l + 1, lds, gw, ngw, wave, lane); grid.sync(); }
      else phase_ln(a, S_LAT, a->in[6] + (size_t)(l * 2 + 1) * DM, a->in[7] + (size_t)(l * 2 + 1) * DM, nullptr, a->out, gw, ngw, lane); }
}

__global__ void __launch_bounds__(512, 2) mk_fwd(Args a_by_value) {
    extern __shared__ __attribute__((aligned(16))) unsigned char lds_raw[];
    cg::grid_group grid = cg::this_grid();
    const ArgsP ap = (ArgsP)__builtin_amdgcn_kernarg_segment_ptr();
    {
        LAS unsigned char* lds = (LAS unsigned char*)lds_raw;
        const int tid = threadIdx.x, lane = tid & 63, wave = __builtin_amdgcn_readfirstlane(tid >> 6);
        const int G = gridDim.x, bid = blockIdx.x, gw = bid * 8 + wave, ngw = G * 8;
        phase_adaln(relaunder(ap), lds, bid, G, tid, wave, lane);
        if (bid == G - 1) rope_tables(relaunder(ap), tid);
        convert_layer(relaunder(ap), 0, lds, gw, ngw, wave, lane);
        grid.sync();
        phase_init(relaunder(ap), gw, ngw, lane);
        grid.sync();
    }
    run_layer<0>(ap, lds_raw, nullptr);
    run_layer<1>(ap, lds_raw, nullptr);
    run_layer<2>(ap, lds_raw, nullptr);
    run_layer<3>(ap, lds_raw, nullptr);
}

extern "C" void kernel_launch(void* const* d_in, const int* in_sizes, int n_in, void* d_out, int out_size, void* d_ws, size_t ws_size, hipStream_t stream) {
    static int grid = 0;
    if (grid == 0) {
        if (n_in != 20 || out_size != S_LAT * DM || ws_size < WS_END) { fprintf(stderr, "kernel_launch: unexpected problem (n_in %d, out %d, ws %zu < %zu)\n", n_in, out_size, ws_size, (size_t)WS_END); grid = -1; return; }
        int dev = 0, cus = 0, per_cu = 0;
        (void)hipGetDevice(&dev); (void)hipDeviceGetAttribute(&cus, hipDeviceAttributeMultiprocessorCount, dev);
        if (hipFuncSetAttribute((const void*)mk_fwd, hipFuncAttributeMaxDynamicSharedMemorySize, LDS_BYTES) != hipSuccess) { fprintf(stderr, "kernel_launch: hipFuncSetAttribute failed\n"); grid = -1; return; }
        if (hipOccupancyMaxActiveBlocksPerMultiprocessor(&per_cu, (const void*)mk_fwd, 512, LDS_BYTES) != hipSuccess || per_cu < 1) { fprintf(stderr, "kernel_launch: occupancy query says %d\n", per_cu); per_cu = 1; }
        (void)hipGetLastError();
        grid = cus * 1;
        if (grid <= 0) grid = 256;
    }
    if (grid < 0) return;
    Args a{};
    for (int i = 0; i < 20; ++i) a.in[i] = (const float*)d_in[i];
    a.out = (float*)d_out; a.ws = (unsigned char*)d_ws;
    void* args[] = {&a};
    hipError_t e = hipLaunchCooperativeKernel((const void*)mk_fwd, dim3(grid), dim3(512), args, LDS_BYTES, stream);
    if (e != hipSuccess) fprintf(stderr, "cooperative launch failed: %s (grid %d)\n", hipGetErrorString(e), grid);
}
```

```cpp
#include <hip/hip_runtime.h>
#include <hip/hip_cooperative_groups.h>
#include <hip/hip_bf16.h>
#include <cstdio>
#include <cstdint>
#include <cmath>
namespace cg = cooperative_groups;
namespace pg8 {
#define PG8_LAS __attribute__((address_space(3)))
typedef unsigned short bf16_t;
typedef short bf16x8 __attribute__((ext_vector_type(8)));
typedef float f32x4 __attribute__((ext_vector_type(4)));
typedef unsigned u32x4 __attribute__((ext_vector_type(4)));
constexpr int BM = 256, BK = 64, HALF = 128, HTB = HALF * BK * 2  , STAGE_BYTES = 8 * HTB, NXCD = 8, WGM = 8;

__host__ __device__ __forceinline__ int lds_byte(int r, int c) { const int st = (r >> 4) * 2 + (c >> 5), rr = r & 15, cc = c & 31, ob = rr * 64 + cc * 2; return st * 1024 + (ob ^ (((ob >> 9) & 1) << 5)); }
__host__ __device__ __forceinline__ void stage_rc(int b, int& R, int& C) { const int st = b / 1024, sb = b % 1024, swz = sb ^ (((sb >> 9) & 1) << 5); R = (st >> 1) * 16 + swz / 64; C = (st & 1) * 32 + (swz % 64) / 2; }
__host__ __device__ __forceinline__ int perm32(int rho) { const int n = rho >> 4, i = rho & 15; return 8 * (i >> 2) + 4 * n + (i & 3); }

struct Unit { int pm, pn; };
struct Gemm { const bf16_t* A; const bf16_t* Bt; int M, N, K; };

struct StaticOrder {
    int nM, nN, nwg, G, c;
    __host__ __device__ void init(int M, int N, int G_, int c_) { nM = M / BM; nN = N / BM; nwg = nM * nN; G = G_; c = c_; }
    __host__ __device__ bool next(int i, Unit& u) const {
        const long L = (long)i * G + c; if (L >= nwg) return false;
        int wgid = (int)L; { const int q = nwg / NXCD, r = nwg % NXCD, xcd = wgid % NXCD, off = wgid / NXCD; wgid = (xcd < r ? xcd * (q + 1) : r * (q + 1) + (xcd - r) * q) + off; }
        const int nig = WGM * nN, gid = wgid / nig, fm = gid * WGM, gsz = (nM - fm) < WGM ? (nM - fm) : WGM;
        u.pm = fm + ((wgid % nig) % gsz); u.pn = (wgid % nig) / gsz; return true;
    }
    __device__ __forceinline__ void a_ready(const Unit&) const {}
    __device__ __forceinline__ void done(const Unit&) const {}
};

__device__ __forceinline__ unsigned cvt_pk_bf16(float lo, float hi) { unsigned r; asm volatile("v_cvt_pk_bf16_f32 %0, %1, %2" : "=v"(r) : "v"(lo), "v"(hi)); return r; }
typedef float f32x2 __attribute__((ext_vector_type(2)));
__device__ __forceinline__ unsigned pk_bf16(float lo, float hi) { typedef float f2 __attribute__((ext_vector_type(2))); typedef __bf16 b2 __attribute__((ext_vector_type(2))); f2 v = {lo, hi}; b2 b = __builtin_convertvector(v, b2); return __builtin_bit_cast(unsigned, b); }

struct EpiInproj {
    static constexpr bool PERM = true, AFTER_DRAIN = false;
    bf16_t* O; int ldc;
    const float* qg; const float* kg;
    const float* cosT; const float* sinT;
    int rmsq_end, rms_end, rope_end, sc1_end, sc2_beg, sc2_end;
    float c2;
    __device__ __forceinline__ void operator()(const f32x4 (&acc)[2][2][4][2], const Unit& u, int wr, int wc, int fr, int fq) const {
        const int hb = u.pn * BM + wc * 64;
        const bool do_rms = hb < rms_end, do_rope = hb < rope_end;
        const float sc = (hb < sc1_end || (hb >= sc2_beg && hb < sc2_end)) ? c2 : 1.f;
        f32x4 gv[2][2];
#pragma unroll
        for (int bj = 0; bj < 2; ++bj)
#pragma unroll
            for (int n = 0; n < 2; ++n) gv[bj][n] = do_rms ? *(const f32x4*)((hb < rmsq_end ? qg : kg) + 32 * bj + 16 * n + 4 * fq) : (f32x4){1.f, 1.f, 1.f, 1.f};
#pragma unroll
        for (int ai = 0; ai < 2; ++ai)
#pragma unroll
            for (int m = 0; m < 4; ++m) {
                const int row = u.pm * BM + ai * HALF + wr * 64 + m * 16 + fr;
                f32x4 v[2][2];
#pragma unroll
                for (int bj = 0; bj < 2; ++bj)
#pragma unroll
                    for (int n = 0; n < 2; ++n) v[bj][n] = acc[ai][bj][m][n];
                if (do_rms) {
                    float ss = 0.f;
#pragma unroll
                    for (int bj = 0; bj < 2; ++bj)
#pragma unroll
                        for (int n = 0; n < 2; ++n) { const f32x4 x = v[bj][n]; ss += (x[0] * x[0] + x[1] * x[1]) + (x[2] * x[2] + x[3] * x[3]); }
                    ss += __shfl_xor(ss, 16); ss += __shfl_xor(ss, 32);
                    const float rinv = 1.0f / sqrtf(ss * (1.0f / 64.0f) + 1e-6f);
#pragma unroll
                    for (int bj = 0; bj < 2; ++bj)
#pragma unroll
                        for (int n = 0; n < 2; ++n) v[bj][n] = v[bj][n] * rinv * gv[bj][n];
                }
                if (do_rope && row < 16384) {
#pragma unroll
                    for (int bj = 0; bj < 2; ++bj) {
                        const int pos = bj ? (row & 63) : (row >> 6);
                        const f32x4 cs = *(const f32x4*)(cosT + pos * 16 + 4 * fq), sn = *(const f32x4*)(sinT + pos * 16 + 4 * fq);
                        const f32x4 x1 = v[bj][0], x2 = v[bj][1];
                        v[bj][0] = x1 * cs - x2 * sn; v[bj][1] = x2 * cs + x1 * sn;
                    }
                }
                bf16_t* rowp = O + (size_t)row * ldc + hb + 8 * fq;
#pragma unroll
                for (int bj = 0; bj < 2; ++bj) {
                    const f32x4 a = v[bj][0] * sc, b = v[bj][1] * sc;
                    u32x4 w; w.x = pk_bf16(a[0], a[1]); w.y = pk_bf16(a[2], a[3]); w.z = pk_bf16(b[0], b[1]); w.w = pk_bf16(b[2], b[3]);
                    *(u32x4*)(rowp + 32 * bj) = w;
                }
                asm volatile("" ::: "memory");
            }
    }
};
struct EpiResid {
    static constexpr bool PERM = true, AFTER_DRAIN = false;
    float* XS; const float* gate_lat; const float* gate_ctx; float alpha;
    __device__ __forceinline__ void operator()(const f32x4 (&acc)[2][2][4][2], const Unit& u, int wr, int wc, int fr, int fq) const {
        const float* gate = (u.pm >= 64) ? gate_ctx : gate_lat;
        const int col0 = u.pn * BM + wc * 32 + 8 * fq;
        f32x4 gv[2][2];
#pragma unroll
        for (int bj = 0; bj < 2; ++bj)
#pragma unroll
            for (int n = 0; n < 2; ++n) gv[bj][n] = *(const f32x4*)(gate + col0 + bj * HALF + 4 * n);
#pragma unroll
        for (int ai = 0; ai < 2; ++ai)
#pragma unroll
            for (int m = 0; m < 4; ++m) {
                float* rowp = XS + (size_t)(u.pm * BM + ai * HALF + wr * 64 + m * 16 + fr) * 1024 + col0;
#pragma unroll
                for (int bj = 0; bj < 2; ++bj)
#pragma unroll
                    for (int n = 0; n < 2; ++n) { f32x4* p = (f32x4*)(rowp + bj * HALF + 4 * n); const f32x4 x = *p; *p = x * alpha + gv[bj][n] * acc[ai][bj][m][n]; }
                if (m & 1) asm volatile("" ::: "memory");
            }
    }
};
struct EpiStore {
    static constexpr bool PERM = true, AFTER_DRAIN = false;
    bf16_t* O; int ldc;
    __device__ __forceinline__ void operator()(const f32x4 (&acc)[2][2][4][2], const Unit& u, int wr, int wc, int fr, int fq) const {
        const int col0 = u.pn * BM + wc * 32 + 8 * fq;
#pragma unroll
        for (int ai = 0; ai < 2; ++ai)
#pragma unroll
            for (int m = 0; m < 4; ++m) {
                bf16_t* rowp = O + (size_t)(u.pm * BM + ai * HALF + wr * 64 + m * 16 + fr) * ldc + col0;
#pragma unroll
                for (int bj = 0; bj < 2; ++bj) { const f32x4 a = acc[ai][bj][m][0], b = acc[ai][bj][m][1];
                    u32x4 w; w.x = pk_bf16(a[0], a[1]); w.y = pk_bf16(a[2], a[3]); w.z = pk_bf16(b[0], b[1]); w.w = pk_bf16(b[2], b[3]);
                    *(u32x4*)(rowp + bj * HALF) = w; }
            }
    }
};
template <class Epi, class Sched, bool ALIGN_EPI = false, bool SP2 = false>
__device__ __forceinline__ void gemm_phase(PG8_LAS unsigned char* lds, const Gemm g, const Sched& S, const Epi& E) {
    int tid = threadIdx.x; asm volatile("" : "+v"(tid));
    const int wid = __builtin_amdgcn_readfirstlane(tid >> 6), lane = tid & 63, wr = wid >> 2, wc = wid & 3, fr = lane & 15, fq = lane >> 4;
    const int K = g.K, nt = K / BK;
    unsigned voffA[2], voffB[2];
#pragma unroll
    for (int i = 0; i < 2; ++i) { int R, C; stage_rc(tid * 16 + i * 8192, R, C); const int Rb = Epi::PERM ? ((R & ~31) + perm32(R & 31)) : R;
        voffA[i] = (unsigned)(R * K + C) * 2u; voffB[i] = (unsigned)(Rb * K + C) * 2u; }
    const size_t kstep = (size_t)(BK * 2);
    const size_t hstep = (size_t)HALF * K * 2;
    const size_t tstep = 2 * hstep;
    const unsigned ldsw = (unsigned)wid * 1024u;
    const int aoff = lds_byte(wr * 64 + fr, fq * 8), boff = lds_byte(wc * 32 + fr, fq * 8);
#define PG8_SA(b, h) (((b) * 2 + (h)) * HTB)
#define PG8_SB(b, h) ((4 + (b) * 2 + (h)) * HTB)
#define PG8_STAGE(bufoff, gbase, voff) do { _Pragma("unroll") for (int _i = 0; _i < 2; ++_i) \
        __builtin_amdgcn_global_load_lds((const unsigned*)((const char*)(gbase) + (voff)[_i]), (PG8_LAS unsigned*)(lds + (bufoff) + ldsw + _i * 8192), 16, 0, 0); } while (0)
#define PG8_LDA(dst, b, h) do { _Pragma("unroll") for (int m = 0; m < 4; ++m) _Pragma("unroll") for (int k = 0; k < 2; ++k) dst[m][k] = *(const PG8_LAS bf16x8*)(lds + PG8_SA(b, h) + aoff + m * 2048 + k * 1024); } while (0)
#define PG8_LDB(dst, b, h) do { _Pragma("unroll") for (int n = 0; n < 2; ++n) _Pragma("unroll") for (int k = 0; k < 2; ++k) dst[n][k] = *(const PG8_LAS bf16x8*)(lds + PG8_SB(b, h) + boff + n * 2048 + k * 1024); } while (0)
#define PG8_MMA(ai, bj, At, Bt) do { __builtin_amdgcn_s_setprio(1); _Pragma("unroll") for (int m = 0; m < 4; ++m) _Pragma("unroll") for (int n = 0; n < 2; ++n) _Pragma("unroll") for (int k = 0; k < 2; ++k) \
        acc[ai][bj][m][n] = __builtin_amdgcn_mfma_f32_16x16x32_bf16(Bt[n][k], At[m][k], acc[ai][bj][m][n], 0, 0, 0); __builtin_amdgcn_s_setprio(0); } while (0)
#define PG8_WAIT_V(n) asm volatile("s_waitcnt vmcnt(" #n ")" ::: "memory")
#define PG8_WAIT_L(n) asm volatile("s_waitcnt lgkmcnt(" #n ")" ::: "memory")
#define PG8_BAR __builtin_amdgcn_s_barrier()
#define PG8_SCHED __builtin_amdgcn_sched_barrier(0)
    Unit cur, nxt; int ui = 0;
    if (!S.next(0, cur)) return;
    f32x4 acc[2][2][4][2];
#pragma unroll
    for (int a = 0; a < 2; ++a)
#pragma unroll
        for (int b = 0; b < 2; ++b)
#pragma unroll
            for (int m = 0; m < 4; ++m)
#pragma unroll
                for (int n = 0; n < 2; ++n) acc[a][b][m][n] = (f32x4){0.f, 0.f, 0.f, 0.f};
    bf16x8 At[4][2], B0[2][2], B1[2][2];
    const char* cA = (const char*)g.A + (size_t)cur.pm * tstep; const char* cB = (const char*)g.Bt + (size_t)cur.pn * tstep;
    S.a_ready(cur);
    if constexpr (SP2) {
        PG8_STAGE(PG8_SB(0, 0), cB, voffB); PG8_STAGE(PG8_SB(0, 1), cB + hstep, voffB); PG8_STAGE(PG8_SA(0, 0), cA, voffA); PG8_STAGE(PG8_SA(0, 1), cA + hstep, voffA);
        if (wr == 1) PG8_BAR;
        PG8_WAIT_V(2); PG8_BAR;
        PG8_STAGE(PG8_SB(1, 0), cB + kstep, voffB); PG8_STAGE(PG8_SA(1, 0), cA + kstep, voffA); PG8_STAGE(PG8_SB(1, 1), cB + hstep + kstep, voffB);
        PG8_WAIT_V(6); PG8_BAR;
    } else {
        PG8_STAGE(PG8_SB(0, 0), cB, voffB); PG8_STAGE(PG8_SA(0, 0), cA, voffA); PG8_STAGE(PG8_SB(0, 1), cB + hstep, voffB); PG8_STAGE(PG8_SA(0, 1), cA + hstep, voffA);
        if (wr == 1) PG8_BAR;
        PG8_WAIT_V(4); PG8_BAR;
        PG8_STAGE(PG8_SB(1, 0), cB + kstep, voffB); PG8_STAGE(PG8_SA(1, 0), cA + kstep, voffA); PG8_STAGE(PG8_SB(1, 1), cB + hstep + kstep, voffB);
        PG8_WAIT_V(6); PG8_BAR;
    }
    for (;;) {
        const bool has_next = S.next(ui + 1, nxt);
        const char* nA = has_next ? (const char*)g.A + (size_t)nxt.pm * tstep : cA; const char* nB = has_next ? (const char*)g.Bt + (size_t)nxt.pn * tstep : cB;
        for (int t = 0; t < nt; t += 2) {
            const bool last = (t == nt - 2);
            const char* a1 = cA + (size_t)(t + 1) * kstep;
            const char* a2 = last ? nA : cA + (size_t)(t + 2) * kstep; const char* b2 = last ? nB : cB + (size_t)(t + 2) * kstep;
            const char* a3 = a2 + kstep; const char* b3 = b2 + kstep;
            if (last && has_next) S.a_ready(nxt);
            if constexpr (SP2) {
            PG8_LDB(B0, 0, 0); PG8_LDB(B1, 0, 1); PG8_SCHED; PG8_LDA(At, 0, 0); PG8_STAGE(PG8_SA(1, 1), a1 + hstep, voffA);
            PG8_WAIT_V(8); PG8_WAIT_L(0); PG8_BAR; PG8_MMA(0, 0, At, B0); PG8_MMA(0, 1, At, B1); PG8_BAR; PG8_SCHED;
            PG8_LDA(At, 0, 1); PG8_STAGE(PG8_SB(0, 0), b2, voffB); PG8_STAGE(PG8_SB(0, 1), b2 + hstep, voffB); PG8_STAGE(PG8_SA(0, 0), a2, voffA);
            PG8_WAIT_V(8); PG8_WAIT_L(0); PG8_BAR; PG8_MMA(1, 0, At, B0); PG8_MMA(1, 1, At, B1); PG8_BAR; PG8_SCHED;
            PG8_LDB(B0, 1, 0); PG8_LDB(B1, 1, 1); PG8_SCHED; PG8_LDA(At, 1, 0); PG8_STAGE(PG8_SA(0, 1), a2 + hstep, voffA);
            PG8_WAIT_V(8); PG8_WAIT_L(0); PG8_BAR; PG8_MMA(0, 0, At, B0); PG8_MMA(0, 1, At, B1); PG8_BAR; PG8_SCHED;
            PG8_LDA(At, 1, 1); PG8_STAGE(PG8_SB(1, 0), b3, voffB); PG8_STAGE(PG8_SB(1, 1), b3 + hstep, voffB); PG8_STAGE(PG8_SA(1, 0), a3, voffA);
            PG8_WAIT_V(8); PG8_WAIT_L(0); PG8_BAR; PG8_MMA(1, 0, At, B0); PG8_MMA(1, 1, At, B1); PG8_BAR; PG8_SCHED;
            } else {
            PG8_LDB(B0, 0, 0); PG8_SCHED; PG8_LDA(At, 0, 0); PG8_STAGE(PG8_SA(1, 1), a1 + hstep, voffA);
            PG8_WAIT_L(8); PG8_BAR; PG8_WAIT_L(0); PG8_MMA(0, 0, At, B0); PG8_BAR; PG8_SCHED;
            PG8_LDB(B1, 0, 1); PG8_STAGE(PG8_SB(0, 0), b2, voffB);
            PG8_BAR; PG8_WAIT_L(0); PG8_MMA(0, 1, At, B1); PG8_BAR;
            PG8_LDA(At, 0, 1); PG8_STAGE(PG8_SA(0, 0), a2, voffA);
            PG8_BAR; PG8_WAIT_L(0); PG8_MMA(1, 0, At, B0); PG8_BAR; PG8_SCHED;
            PG8_STAGE(PG8_SB(0, 1), b2 + hstep, voffB);
            PG8_WAIT_V(6); PG8_BAR; PG8_MMA(1, 1, At, B1); PG8_BAR;
            PG8_LDB(B0, 1, 0); PG8_SCHED; PG8_LDA(At, 1, 0); PG8_STAGE(PG8_SA(0, 1), a2 + hstep, voffA);
            PG8_WAIT_L(8); PG8_BAR; PG8_WAIT_L(0); PG8_MMA(0, 0, At, B0); PG8_BAR; PG8_SCHED;
            PG8_LDB(B1, 1, 1); PG8_STAGE(PG8_SB(1, 0), b3, voffB);
            PG8_BAR; PG8_WAIT_L(0); PG8_MMA(0, 1, At, B1); PG8_BAR;
            PG8_LDA(At, 1, 1); PG8_STAGE(PG8_SA(1, 0), a3, voffA);
            PG8_BAR; PG8_WAIT_L(0); PG8_MMA(1, 0, At, B0); PG8_BAR; PG8_SCHED;
            PG8_STAGE(PG8_SB(1, 1), b3 + hstep, voffB);
            PG8_WAIT_V(6); PG8_BAR; PG8_MMA(1, 1, At, B1); PG8_BAR;
            }
        }
        if constexpr (ALIGN_EPI) { if (wr == 0) PG8_BAR; }
        if constexpr (!Epi::AFTER_DRAIN) { E(acc, cur, wr, wc, fr, fq); S.done(cur); }
        if (!has_next) break;
#pragma unroll
        for (int a = 0; a < 2; ++a)
#pragma unroll
            for (int b = 0; b < 2; ++b)
#pragma unroll
                for (int m = 0; m < 4; ++m)
#pragma unroll
                    for (int n = 0; n < 2; ++n) acc[a][b][m][n] = (f32x4){0.f, 0.f, 0.f, 0.f};
        cur = nxt; cA = nA; cB = nB; ++ui;
        if constexpr (ALIGN_EPI) { if (wr == 1) PG8_BAR; }
    }
    PG8_WAIT_V(0);
    if constexpr (!ALIGN_EPI) { if (wr == 0) PG8_BAR; }
    PG8_BAR;
    if constexpr (Epi::AFTER_DRAIN) { E.fused(acc, cur, wr, wc, fr, fq, lds, wid, lane); S.done(cur); }
#undef PG8_SA
#undef PG8_SB
#undef PG8_STAGE
#undef PG8_LDA
#undef PG8_LDB
#undef PG8_MMA
#undef PG8_WAIT_V
#undef PG8_WAIT_L
#undef PG8_BAR
#undef PG8_SCHED
}
}
namespace attn_body {
using bf16=__hip_bfloat16;
using bf16x8=__attribute__((ext_vector_type(8)))short;
using s16x4=__attribute__((ext_vector_type(4)))short;
using f32x16=__attribute__((ext_vector_type(16)))float;
using u32x4=__attribute__((ext_vector_type(4)))unsigned;
constexpr int D=64,QP=2304,KP=2304,OP=1024,NTILES=260;
constexpr int NW=8,QBLK=32,QB=QBLK*NW,KVBLK=64;
__device__ __forceinline__ int crow(int r,int hi){return (r&3)+8*(r>>2)+4*hi;}
#define SBAR() __builtin_amdgcn_sched_barrier(0)
__device__ __forceinline__ void cmask(f32x16&p0,f32x16&p1,int jb,int qrel,int hi){
  const float NEG=-INFINITY; int kb=64*jb+4*hi;
  #pragma unroll
  for(int r=0;r<16;++r){int kv=kb+(r&3)+8*(r>>2); if(kv>qrel)p0[r]=NEG; if(kv+32>qrel)p1[r]=NEG;}
}

constexpr int NSLOT=3, SLOTB=8192;
constexpr int LDS_K=0, LDS_V=NSLOT*SLOTB, LDS_WS=2*NSLOT*SLOTB, LDS_OST=LDS_WS+NW*64*4, LDS_BYTES=LDS_OST+NW*4096;
constexpr float C2=0.125f*1.4426950408889634f;
__device__ __forceinline__ void glds16(const void*gsrc,unsigned lds_dst){unsigned keep;
  asm volatile("s_mov_b32 %0, m0\n\ts_mov_b32 m0, %2\n\ts_nop 0\n\tglobal_load_lds_dwordx4 %1, off\n\ts_mov_b32 m0, %0":"=&s"(keep):"v"(gsrc),"s"(lds_dst):"memory");}
__device__ __forceinline__ float max3f(float a,float b,float c){float r;asm("v_max3_f32 %0, %1, %2, %3":"=v"(r):"v"(a),"v"(b),"v"(c));return r;}
__device__ __forceinline__ float max2f(float a,float b){float r;asm("v_max_f32_e32 %0, %1, %2":"=v"(r):"v"(a),"v"(b));return r;}
__device__ __forceinline__ float fadd_s(float a,float b){float r;asm("v_add_f32_e32 %0, %1, %2":"=v"(r):"v"(a),"v"(b));return r;}
__device__ __forceinline__ float fsub_s(float a,float b){float r;asm("v_sub_f32_e32 %0, %1, %2":"=v"(r):"v"(a),"v"(b));return r;}
typedef float f32x2_t __attribute__((ext_vector_type(2))); typedef __bf16 bf16x2_t __attribute__((ext_vector_type(2)));
__device__ __forceinline__ unsigned cvtpk_s(float lo,float hi){f32x2_t v={lo,hi};bf16x2_t b=__builtin_convertvector(v,bf16x2_t);return __builtin_bit_cast(unsigned,b);}
#define WAIT_BAR(N) asm volatile("s_waitcnt vmcnt(" #N ") lgkmcnt(0)\n\ts_barrier":::"memory")

__device__ __forceinline__ void qkt(f32x16&p0,f32x16&p1,const char*Kslot,const bf16x8*qr,const f32x16&negm,int r32,int hi){
  const char*kb=Kslot+hi*1024+r32*16;
  #pragma unroll
  for(int d0=0;d0<4;++d0){
    const bf16x8 b0=*reinterpret_cast<const bf16x8*>(kb+d0*2048);
    const bf16x8 b1=*reinterpret_cast<const bf16x8*>(kb+d0*2048+512);
    if(d0==0){p0=__builtin_amdgcn_mfma_f32_32x32x16_bf16(b0,qr[0],negm,0,0,0);p1=__builtin_amdgcn_mfma_f32_32x32x16_bf16(b1,qr[0],negm,0,0,0);}
    else{p0=__builtin_amdgcn_mfma_f32_32x32x16_bf16(b0,qr[d0],p0,0,0,0);p1=__builtin_amdgcn_mfma_f32_32x32x16_bf16(b1,qr[d0],p1,0,0,0);}}
}
typedef __attribute__((address_space(3))) const char* lds_cptr;
typedef short v4i16_t __attribute__((ext_vector_type(4)));
__device__ __forceinline__ void kload8(bf16x8*kf,lds_cptr kp){
  kf[0]=*(const __attribute__((address_space(3))) bf16x8*)(kp);      kf[1]=*(const __attribute__((address_space(3))) bf16x8*)(kp+512);
  kf[2]=*(const __attribute__((address_space(3))) bf16x8*)(kp+2048); kf[3]=*(const __attribute__((address_space(3))) bf16x8*)(kp+2560);
  kf[4]=*(const __attribute__((address_space(3))) bf16x8*)(kp+4096); kf[5]=*(const __attribute__((address_space(3))) bf16x8*)(kp+4608);
  kf[6]=*(const __attribute__((address_space(3))) bf16x8*)(kp+6144); kf[7]=*(const __attribute__((address_space(3))) bf16x8*)(kp+6656);
}
__device__ __forceinline__ void kload2(bf16x8*kf,lds_cptr kp,int j){ kf[2*j]=*(const __attribute__((address_space(3))) bf16x8*)(kp+j*2048); kf[2*j+1]=*(const __attribute__((address_space(3))) bf16x8*)(kp+j*2048+512); }
__device__ __forceinline__ s16x4 vtr(lds_cptr p){ return __builtin_bit_cast(s16x4,__builtin_amdgcn_ds_read_tr16_b64_v4i16((__attribute__((address_space(3))) v4i16_t*)p)); }
__device__ __forceinline__ float rowmax(const f32x16&p0,const f32x16&p1){
  float a=max3f(p0[0],p0[1],p1[0]),b=max3f(p0[2],p0[3],p1[1]);a=max3f(a,p1[2],p1[3]);
  #pragma unroll
  for(int r=4;r<16;r+=4){a=max3f(a,p0[r],p0[r+1]);b=max3f(b,p0[r+2],p0[r+3]);a=max3f(a,p1[r],p1[r+1]);b=max3f(b,p1[r+2],p1[r+3]);}
  const float m=max2f(a,b);
  auto rr=__builtin_amdgcn_permlane32_swap(__float_as_uint(m),__float_as_uint(m),false,false);
  return max2f(__uint_as_float(rr[0]),__uint_as_float(rr[1]));
}
__device__ __forceinline__ void pv(f32x16*o,int vb,bf16x8 pa0,bf16x8 pa1,bf16x8 pa2,bf16x8 pa3){
  #pragma unroll
  for(int d0=0;d0<2;++d0){s16x4 lo[4],hi[4];
    #pragma unroll
    for(int ks=0;ks<4;++ks){
      asm volatile("ds_read_b64_tr_b16 %0,%1 offset:%c2":"=&v"(lo[ks]):"v"(vb),"i"(d0*4096+ks*1024):"memory");
      asm volatile("ds_read_b64_tr_b16 %0,%1 offset:%c2":"=&v"(hi[ks]):"v"(vb),"i"(d0*4096+ks*1024+512):"memory");}
    asm volatile("s_waitcnt lgkmcnt(0)":::"memory");SBAR();
    #define PK(k) (bf16x8){lo[k][0],lo[k][1],lo[k][2],lo[k][3],hi[k][0],hi[k][1],hi[k][2],hi[k][3]}
    o[d0]=__builtin_amdgcn_mfma_f32_32x32x16_bf16(pa0,PK(0),o[d0],0,0,0);
    o[d0]=__builtin_amdgcn_mfma_f32_32x32x16_bf16(pa1,PK(1),o[d0],0,0,0);
    o[d0]=__builtin_amdgcn_mfma_f32_32x32x16_bf16(pa2,PK(2),o[d0],0,0,0);
    o[d0]=__builtin_amdgcn_mfma_f32_32x32x16_bf16(pa3,PK(3),o[d0],0,0,0);
    #undef PK
  }
}

#ifndef ATTN_STORE16
#define ATTN_STORE16(p,v) (*(u32x4*)(p)=(v))
#endif
template<int THRL> __device__ __forceinline__ void attn_unit(int qb,const bf16*Q,const bf16*__restrict__ K,const bf16*__restrict__ V,bf16*O,char*shm){
  int tid=threadIdx.x; asm volatile("":"+v"(tid)); const int lane=tid&63,r32=lane&31,hi=lane>>5; const int wid=__builtin_amdgcn_readfirstlane(tid>>6);
  const int q0=qb*QB;
  const bf16*Qw=Q+(long)(q0+wid*QBLK)*QP;
  const bf16*Kh=K,*Vh=V;
  const unsigned lds0=(unsigned)(uintptr_t)shm;
  float*wsf=(float*)(shm+LDS_WS)+wid*64;
  const bf16*ksrc=Kh+(long)lane*KP+wid*8;
  const bf16*vsrc=Vh+(long)(16*(wid&3)+(lane>>2))*KP+(wid>>2)*32+(lane&3)*8;
  const unsigned kdst=lds0+LDS_K+wid*1024, vdst=lds0+LDS_V+wid*1024;
  #define DMA_K(t,slot) glds16(ksrc+(long)(t)*KVBLK*KP,(unsigned)__builtin_amdgcn_readfirstlane(kdst+(slot)))
  #define DMA_V(t,slot) glds16(vsrc+(long)(t)*KVBLK*KP,(unsigned)__builtin_amdgcn_readfirstlane(vdst+(slot)))
  const int vb0=(int)(lds0+LDS_V)+((lane>>4)&1)*32+(lane&3)*8+(4*hi+((lane&15)>>2))*64;
  const char*Kbase=shm+LDS_K; bf16x8 kf[8];
  const lds_cptr shm3=(lds_cptr)shm; const lds_cptr kp0=shm3+LDS_K+hi*1024+r32*16; const lds_cptr vp0=shm3+LDS_V+((lane>>4)&1)*32+(lane&3)*8+(4*hi+((lane&15)>>2))*64;
  const int NT=NTILES;
  DMA_K(0,0);DMA_V(0,0);DMA_K(1,SLOTB);
  bf16x8 qr[4];
  #pragma unroll
  for(int d0=0;d0<4;++d0)qr[d0]=*reinterpret_cast<const bf16x8*>(&Qw[(long)r32*QP+d0*16+hi*8]);
  float mhat=0.f,l_reg=0.f;f32x16 o[2];o[0]=f32x16{};o[1]=f32x16{};f32x16 negm=f32x16{};asm volatile("":"+v"(negm));
  const int qrel=wid*QBLK+r32;
  #define CMASK(P0,P1,t) do{}while(0)
  bool resc=false;
  #define START(P0,P1) do{ const float rm=rowmax(P0,P1); resc=false; \
    { const float dl=rm; mhat=fadd_s(mhat,dl); \
      _Pragma("unroll") for(int r=0;r<16;++r){P0[r]=fsub_s(P0[r],dl);P1[r]=fsub_s(P1[r],dl);} \
      _Pragma("unroll") for(int r=0;r<16;++r)negm[r]=-mhat; asm volatile("":"+v"(negm)); } \
    _Pragma("unroll") for(int r=0;r<16;++r)P0[r]=__builtin_amdgcn_exp2f(P0[r]); }while(0)
  #define RESC() do{ if(resc){ asm volatile("s_waitcnt lgkmcnt(0)":::"memory"); \
      _Pragma("unroll") for(int d_=0;d_<2;++d_) _Pragma("unroll") for(int r=0;r<16;++r)o[d_][r]*=wsf[crow(r,hi)]; } }while(0)
  f32x16 pA0,pA1,pB0,pB1;
  int sl_prev=0,sl_cur=0,sl_next=SLOTB;
  #define ROT() do{sl_prev=sl_cur;sl_cur=sl_next;sl_next=(sl_next==(NSLOT-1)*SLOTB)?0:sl_next+SLOTB;}while(0)
  DMA_K(2,2*SLOTB);
  WAIT_BAR(3);
  qkt(pA0,pA1,Kbase,qr,negm,r32,hi);asm volatile("s_nop 15\n\ts_nop 7":"+v"(pA0),"+v"(pA1));CMASK(pA0,pA1,0);
  START(pA0,pA1);
  _Pragma("unroll") for(int r=0;r<16;++r)pA1[r]=__builtin_amdgcn_exp2f(pA1[r]);
  WAIT_BAR(0);
  DMA_K(3,0);DMA_V(1,SLOTB);
  ROT();
  kload8(kf,kp0+sl_cur);
  WAIT_BAR(2);
  s16x4 vlo[8],vhi[8]; u32x4 pw0,pw1,pw2,pw3;
  #define PKW(P,B) cvtpk_s(P[B],P[B+1])
  #define PAF(k) __builtin_bit_cast(bf16x8,pw##k)
  #define VFR(i) (bf16x8){vlo[i][0],vlo[i][1],vlo[i][2],vlo[i][3],vhi[i][0],vhi[i][1],vhi[i][2],vhi[i][3]}
  #define PIN(x) asm volatile("":"+v"(x))
  #define MX3(a,b,c) __builtin_fmaxf(__builtin_fmaxf((a),(b)),(c))
  #define GAPA(MF,A0,A1,A2,A3,W0,W1,PW) do{ MF; sacc+=A0; sacc+=A1; sacc+=A2; sacc+=A3; PIN(sacc); W0; W1; PIN(PW); SBAR(); }while(0)
  #define EX(v) __builtin_amdgcn_exp2f(v)
  #define GAPB(MF,X,B) do{ MF; X[B]=EX(X[B]); X[B+1]=EX(X[B+1]); X[B+2]=EX(X[B+2]); X[B+3]=EX(X[B+3]); PIN(X); SBAR(); }while(0)
  #define VRD(i) do{ vlo[i]=vtr(vp_+(((i)>>2)*4096+((i)&3)*1024)); vhi[i]=vtr(vp_+(((i)>>2)*4096+((i)&3)*1024+512)); }while(0)
  #define KRD(G,j) do{ if(G){ kload2(kf,kp0+sl_next,j); SBAR(); } }while(0)
  #define STEP(C0,C1,P0,P1,t,GK,GV,GL) do{ SBAR(); \
    const lds_cptr vp_=vp0+sl_prev; \
    VRD(0); SBAR(); float sacc=(P0[0]+P0[1]); \
    GAPA(C0=__builtin_amdgcn_mfma_f32_32x32x16_bf16(kf[0],qr[0],negm,0,0,0), P0[2],P0[3],P0[4],P0[5],     pw0[0]=PKW(P0,0), pw0[1]=PKW(P0,2), pw0); \
    VRD(4); SBAR(); GAPA(C1=__builtin_amdgcn_mfma_f32_32x32x16_bf16(kf[1],qr[0],negm,0,0,0), P0[6],P0[7],P0[8],P0[9],     pw0[2]=PKW(P0,4), pw0[3]=PKW(P0,6), pw0); \
    VRD(1); SBAR(); GAPA(C0=__builtin_amdgcn_mfma_f32_32x32x16_bf16(kf[2],qr[1],C0,0,0,0),   P0[10],P0[11],P0[12],P0[13], pw1[0]=PKW(P0,8), pw1[1]=PKW(P0,10), pw1); \
    VRD(5); SBAR(); GAPA(C1=__builtin_amdgcn_mfma_f32_32x32x16_bf16(kf[3],qr[1],C1,0,0,0),   P0[14],P0[15],P1[0],P1[1],   pw1[2]=PKW(P0,12),pw1[3]=PKW(P0,14), pw1); \
    VRD(2); SBAR(); GAPA(C0=__builtin_amdgcn_mfma_f32_32x32x16_bf16(kf[4],qr[2],C0,0,0,0),   P1[2],P1[3],P1[4],P1[5],     pw2[0]=PKW(P1,0), pw2[1]=PKW(P1,2), pw2); \
    VRD(6); SBAR(); GAPA(C1=__builtin_amdgcn_mfma_f32_32x32x16_bf16(kf[5],qr[2],C1,0,0,0),   P1[6],P1[7],P1[8],P1[9],     pw2[2]=PKW(P1,4), pw2[3]=PKW(P1,6), pw2); \
    VRD(3); SBAR(); GAPA(C0=__builtin_amdgcn_mfma_f32_32x32x16_bf16(kf[6],qr[3],C0,0,0,0),   P1[10],P1[11],P1[12],P1[13], pw3[0]=PKW(P1,8), pw3[1]=PKW(P1,10), pw3); \
    VRD(7); SBAR(); GAPA(C1=__builtin_amdgcn_mfma_f32_32x32x16_bf16(kf[7],qr[3],C1,0,0,0),   P1[14],P1[15],0.f,0.f,       pw3[2]=PKW(P1,12),pw3[3]=PKW(P1,14), pw3); \
    l_reg+=sacc; \
    if(GK){DMA_K((t)+3,sl_cur);} if(GV){DMA_V((t)+1,sl_next);} \
    CMASK(C0,C1,t); \
    { float a=MX3(C0[0],C0[1],C1[0]),b=MX3(C0[2],C0[3],C1[1]); a=MX3(a,C1[2],C1[3]); \
      _Pragma("unroll") for(int r=4;r<16;r+=4){a=MX3(a,C0[r],C0[r+1]);b=MX3(b,C0[r+2],C0[r+3]);a=MX3(a,C1[r],C1[r+1]);b=MX3(b,C1[r+2],C1[r+3]);} \
      float rm=__builtin_fmaxf(a,b); { auto rr=__builtin_amdgcn_permlane32_swap(__float_as_uint(rm),__float_as_uint(rm),false,false); rm=__builtin_fmaxf(__uint_as_float(rr[0]),__uint_as_float(rr[1])); } \
      resc=false; \
      if(__builtin_expect(__any(rm>(float)THRL),0)){ const float dl=__builtin_fmaxf(rm,0.f); mhat+=dl; \
        _Pragma("unroll") for(int r=0;r<16;++r){C0[r]-=dl;C1[r]-=dl;} \
        _Pragma("unroll") for(int r=0;r<16;++r)negm[r]=-mhat; asm volatile("":"+v"(negm)); \
        const float f=__builtin_amdgcn_exp2f(-dl); l_reg*=f; if(hi==0)wsf[r32]=f; resc=true; } } \
    SBAR(); \
    GAPB(o[0]=__builtin_amdgcn_mfma_f32_32x32x16_bf16(PAF(0),VFR(0),o[0],0,0,0), C0,0); \
    GAPB(o[1]=__builtin_amdgcn_mfma_f32_32x32x16_bf16(PAF(0),VFR(4),o[1],0,0,0), C0,4); \
    KRD(GL,0); GAPB(o[0]=__builtin_amdgcn_mfma_f32_32x32x16_bf16(PAF(1),VFR(1),o[0],0,0,0), C0,8); \
    KRD(GL,1); GAPB(o[1]=__builtin_amdgcn_mfma_f32_32x32x16_bf16(PAF(1),VFR(5),o[1],0,0,0), C0,12); \
    KRD(GL,2); GAPB(o[0]=__builtin_amdgcn_mfma_f32_32x32x16_bf16(PAF(2),VFR(2),o[0],0,0,0), C1,0); \
    KRD(GL,3); GAPB(o[1]=__builtin_amdgcn_mfma_f32_32x32x16_bf16(PAF(2),VFR(6),o[1],0,0,0), C1,4); \
    GAPB(o[0]=__builtin_amdgcn_mfma_f32_32x32x16_bf16(PAF(3),VFR(3),o[0],0,0,0), C1,8); \
    GAPB(o[1]=__builtin_amdgcn_mfma_f32_32x32x16_bf16(PAF(3),VFR(7),o[1],0,0,0), C1,12); \
    }while(0)
  int t=1;
  #undef CMASK
  #define CMASK(P0,P1,t) do{}while(0)
  for(;t+5<NT;t+=2){
    STEP(pB0,pB1,pA0,pA1,t,true,true,true);     WAIT_BAR(2); RESC(); ROT();
    STEP(pA0,pA1,pB0,pB1,t+1,true,true,true);   WAIT_BAR(2); RESC(); ROT();
  }
  #undef CMASK
  #define CMASK(P0,P1,t) do{}while(0)
  #define ENDW(tt) do{ if((tt)+3<NT){WAIT_BAR(2);} else if((tt)+2<NT){WAIT_BAR(1);} else {WAIT_BAR(0);} }while(0)
  for(;t+1<NT;t+=2){
    STEP(pB0,pB1,pA0,pA1,t,(t+3<NT),(t+1<NT),(t+1<NT));       ENDW(t);   RESC(); ROT();
    STEP(pA0,pA1,pB0,pB1,t+1,(t+4<NT),(t+2<NT),(t+2<NT));     ENDW(t+1); RESC(); ROT();
  }
  STEP(pB0,pB1,pA0,pA1,NT-1,false,false,false); RESC();
  { float sacc=pB0[0]+pB0[1]; _Pragma("unroll") for(int r=2;r<16;++r)sacc+=pB0[r]; _Pragma("unroll") for(int r=0;r<16;++r)sacc+=pB1[r]; l_reg+=sacc;
    pw0=(u32x4){PKW(pB0,0),PKW(pB0,2),PKW(pB0,4),PKW(pB0,6)};pw1=(u32x4){PKW(pB0,8),PKW(pB0,10),PKW(pB0,12),PKW(pB0,14)};pw2=(u32x4){PKW(pB1,0),PKW(pB1,2),PKW(pB1,4),PKW(pB1,6)};pw3=(u32x4){PKW(pB1,8),PKW(pB1,10),PKW(pB1,12),PKW(pB1,14)};
    SBAR(); pv(o,vb0+sl_cur,PAF(0),PAF(1),PAF(2),PAF(3)); }
  #undef PKW
  #undef PAF
  #undef VFR
  #undef PIN
  #undef MX3
  #undef GAPA
  #undef GAPB
  #undef EX
  #undef VRD
  #undef KRD
  #undef STEP
  #undef ENDW
  {auto rr=__builtin_amdgcn_permlane32_swap(__float_as_uint(l_reg),__float_as_uint(l_reg),false,false);l_reg=__uint_as_float(rr[0])+__uint_as_float(rr[1]);}
  if(hi==0)wsf[32+r32]=l_reg;asm volatile("s_waitcnt lgkmcnt(0)":::"memory");
  float rli[16];
  #pragma unroll
  for(int r=0;r<16;++r)rli[r]=__builtin_amdgcn_rcpf(wsf[32+crow(r,hi)]);
  bf16*Ow=O+(long)(q0+wid*QBLK)*OP;
  { bf16*stg=(bf16*)(shm+LDS_OST)+wid*2048;
    #pragma unroll
    for(int r=0;r<16;++r){const int orow=crow(r,hi);
      #pragma unroll
      for(int d0=0;d0<2;++d0)stg[orow*64+d0*32+r32]=__float2bfloat16(o[d0][r]*rli[r]);}
    asm volatile("s_waitcnt lgkmcnt(0)":::"memory");
    #pragma unroll
    for(int i=0;i<4;++i){const int row=i*8+(lane>>3),ch=lane&7; const u32x4 v=*(const u32x4*)(stg+row*64+ch*8); ATTN_STORE16(Ow+(long)row*OP+ch*8,v);} }
  asm volatile("s_waitcnt lgkmcnt(0)\n\ts_barrier":::"memory");
  #undef DMA_K
  #undef DMA_V
  #undef CMASK
  #undef START
  #undef RESC
  #undef ROT
}
constexpr int ATTN_LDS_BYTES=LDS_BYTES;
struct AttnTensors { const bf16* Q; const bf16* K; const bf16* V; bf16* O; };
struct AttnUnit { int bh; int qb; };
}
#define LAS __attribute__((address_space(3)))
typedef unsigned short bf16_t;
typedef short bf16x8 __attribute__((ext_vector_type(8)));
typedef short s16x4 __attribute__((ext_vector_type(4)));
typedef float f32x4 __attribute__((ext_vector_type(4)));
typedef float f32x16 __attribute__((ext_vector_type(16)));
typedef unsigned u32x4 __attribute__((ext_vector_type(4)));
typedef unsigned u32x2 __attribute__((ext_vector_type(2)));

#define XB_TMO      128
#define XB_XCNT(j)  (256  + 64 * (j))
#define XB_XSUB(j)  (1280 + 64 * (j))
#define XB_XGEN(j)  (2304 + 64 * (j))
#define XB_TOP      3328
#define XB_TOPGEN   3392
#define XCD_BAR_WORDS 3456
#define XB_SPIN_CAP (1u << 18)

__device__ __forceinline__ unsigned xb_ld(unsigned* p)              { return __hip_atomic_load(p, __ATOMIC_RELAXED, __HIP_MEMORY_SCOPE_AGENT); }
__device__ __forceinline__ unsigned xb_add(unsigned* p, unsigned v) { return __hip_atomic_fetch_add(p, v, __ATOMIC_RELAXED, __HIP_MEMORY_SCOPE_AGENT); }
__device__ __forceinline__ unsigned xb_xcc_id() { return (unsigned)__builtin_amdgcn_s_getreg((3 << 11) | 20) & 0xFu; }
#define XB_SPIN(cond, bar) do { unsigned _sp = 0; while (cond) { __builtin_amdgcn_s_sleep(1); \
    if ((++_sp & 255u) == 0u) { if (xb_ld(&(bar)[XB_TMO])) break; if (_sp > XB_SPIN_CAP) { atomicAdd(&(bar)[XB_TMO], 1u); break; } } } } while (0)

struct XcdBarrier {
    unsigned* bar; unsigned x;
    volatile LAS unsigned* st;
};

__device__ __forceinline__ XcdBarrier xcd_barrier_post(unsigned* bar, volatile LAS unsigned* st, int tid) {
    XcdBarrier b; b.bar = bar; b.x = xb_xcc_id(); b.st = st;
    if (tid == 0) (void)xb_add(&bar[XB_XCNT(b.x)], 1u);
    return b;
}
__device__ __forceinline__ void xcd_barrier_complete(unsigned* bar, unsigned x, unsigned& nloc, unsigned& nx) {
    const unsigned G = gridDim.x * gridDim.y * gridDim.z;
    unsigned sum, cnt, mine, sp = 0u;
    for (;;) {
        sum = 0u; cnt = 0u; mine = 0u;
#pragma unroll
        for (unsigned j = 0; j < 16; ++j) { const unsigned c = xb_ld(&bar[XB_XCNT(j)]); sum += c; cnt += (c > 0u) ? 1u : 0u; mine = (j == x) ? c : mine; }
        if (sum == G) break;
        __builtin_amdgcn_s_sleep(1);
        if ((++sp & 255u) == 0u) { if (xb_ld(&bar[XB_TMO])) break; if (sp > XB_SPIN_CAP) { atomicAdd(&bar[XB_TMO], 1u); break; } }
    }
    nloc = mine > 0u ? mine : 1u; nx = cnt > 0u ? cnt : 1u;
}

__device__ __forceinline__ void xcd_barrier(const XcdBarrier& b, int tid) {
    asm volatile("s_waitcnt vmcnt(0)" ::: "memory");
    __syncthreads();
    if (tid == 0) {
        unsigned* bar = b.bar;
        __builtin_amdgcn_s_waitcnt(0);
        unsigned nloc = b.st[0], nx = b.st[1];
        if (nloc == 0u) { xcd_barrier_complete(bar, b.x, nloc, nx); b.st[0] = nloc; b.st[1] = nx; }
        const unsigned old = xb_add(&bar[XB_XSUB(b.x)], 1u);
        const unsigned gen = old / nloc;
        if (old + 1u == (gen + 1u) * nloc) {
            __builtin_amdgcn_fence(__ATOMIC_RELEASE, "agent");
            asm volatile("s_waitcnt vmcnt(0)" ::: "memory");
            const unsigned og = xb_add(&bar[XB_TOP], 1u);
            const unsigned tg = og / nx;
            if (og + 1u == (tg + 1u) * nx) xb_add(&bar[XB_TOPGEN], 1u);
            else XB_SPIN(xb_ld(&bar[XB_TOPGEN]) == tg, bar);
            __builtin_amdgcn_fence(__ATOMIC_ACQUIRE, "agent");
            xb_add(&bar[XB_XGEN(b.x)], 1u);
            asm volatile("s_waitcnt vmcnt(0)" ::: "memory");
        } else {
            XB_SPIN(xb_ld(&bar[XB_XGEN(b.x)]) == gen, bar);
            __builtin_amdgcn_fence(__ATOMIC_ACQUIRE, "agent");
            asm volatile("s_waitcnt vmcnt(0)" ::: "memory");
        }
    }
    __syncthreads();
}

constexpr int S_LAT = 16384, N_CTX = 256, MT = 16640, DM = 1024, N_EVEN = 2304, N_ODD = 1280, FF = 2816, NU = 5632, NMOD = 6144;
constexpr float DN_ALPHA = 1.6817928305074290f, LOG2E = 1.4426950408889634f, QC2 = 0.125f * 1.4426950408889634f, LN_EPS = 1e-5f;
constexpr size_t MiB = 1u << 20;
constexpr size_t WS_MODS = 0, WS_BAR = 224 * 1024  , WS_ROPE = 256 * 1024, WS_WIN = 1 * MiB, WS_WOUT = 6 * MiB, WS_WUP = 8 * MiB, WS_WDN = 19 * MiB, WS_XS = 25 * MiB, WS_R1 = 90 * MiB, WS_O = WS_R1 + 74 * MiB,
                 WS_HF = 269 * MiB, WS_XN = WS_HF + 1 * MiB, WS_END = 359 * MiB;
static_assert((size_t)MT * N_EVEN * 2 <= 74 * MiB && WS_R1 + (size_t)MT * NU * 2 <= WS_HF && WS_HF + (size_t)MT * FF * 2 <= WS_END && (size_t)(MT + 512) * DM * 2 + MiB <= (size_t)MT * FF * 2, "ws map");
constexpr int LDS_BYTES = 147456 + 64, LDS_BARST = 147456;

struct Args { const float* in[20]; float* out; unsigned char* ws; };
typedef const __attribute__((address_space(4))) Args* ArgsP;
__device__ __forceinline__ ArgsP relaunder(ArgsP p) { asm volatile("" : "+s"(p)); return p; }

__device__ __forceinline__ unsigned pk2(float lo, float hi) { return pg8::pk_bf16(lo, hi); }
__device__ __forceinline__ float bf_lo(unsigned w) { return __uint_as_float(w << 16); }
__device__ __forceinline__ float bf_hi(unsigned w) { return __uint_as_float(w & 0xffff0000u); }
__device__ __forceinline__ float wave_sum(float v) {
#pragma unroll
    for (int o = 1; o < 64; o <<= 1) v += __shfl_xor(v, o);
    return v;
}
__device__ __forceinline__ float silu_f(float v) { return v / (1.0f + __expf(-v)); }

template <int KIND> __device__ __forceinline__ int cmap(int cp) {
    if (KIND == 0) return cp;
    if (KIND == 3) { const int pn = cp >> 8, bj = (cp >> 7) & 1, x = cp & 127; return FF * bj + 128 * pn + x; }
    const int pn = cp >> 8, bj = (cp >> 7) & 1, wc = (cp >> 5) & 3, p = cp & 31, hb = 256 * pn + 64 * wc;
    const bool rope = hb < (KIND == 1 ? 640 : 1152);
    const int d32 = rope ? (16 * ((p >> 2) & 1) + 4 * (p >> 3) + (p & 3)) : p;
    return hb + 32 * bj + d32;
}
template <int KIND> __device__ __forceinline__ void transpose_item(const float* W, int K, int N, bf16_t* WT, LAS float* scr, int item, int lane) {
    const int nblk = N / 32, kb = item / nblk, nb = item % nblk, k0 = 64 * kb, n0 = 32 * nb;
    const int o0 = cmap<KIND>(n0) & ~31;
#pragma unroll 8
    for (int i = 0; i < 32; ++i) { const int kk = 2 * i + (lane >> 5); scr[kk * 33 + (lane & 31)] = W[(size_t)(k0 + kk) * N + o0 + (lane & 31)]; }
    asm volatile("s_waitcnt lgkmcnt(0)" ::: "memory");
    const int c = lane & 7;
#pragma unroll
    for (int j = 0; j < 4; ++j) { const int n = (lane >> 3) + 8 * j; const int sidx = cmap<KIND>(n0 + n) - o0; const LAS float* s = scr + (8 * c) * 33 + sidx;
        u32x4 o; o.x = pk2(s[0 * 33], s[1 * 33]); o.y = pk2(s[2 * 33], s[3 * 33]); o.z = pk2(s[4 * 33], s[5 * 33]); o.w = pk2(s[6 * 33], s[7 * 33]);
        *(u32x4*)(WT + (size_t)(n0 + n) * K + k0 + 8 * c) = o; }
    asm volatile("s_waitcnt lgkmcnt(0)" ::: "memory");
}
__device__ __forceinline__ void convert_layer(ArgsP a, int l, LAS unsigned char* lds, int gw, int ngw, int wave, int lane) {
    LAS float* scr = (LAS float*)(lds + wave * 16384);
    unsigned char* ws = a->ws;
    const int i = l >> 1; const bool odd = l & 1;
    const int n_in = odd ? N_ODD : N_EVEN;
    const float* w_in = odd ? a->in[13] + (size_t)i * DM * N_ODD : a->in[8] + (size_t)i * DM * N_EVEN;
    const float* w_out = (odd ? a->in[14] : a->in[9]) + (size_t)i * DM * DM;
    const float* w_up = a->in[16] + (size_t)l * DM * NU;
    const float* w_dn = a->in[19] + (size_t)l * FF * DM;
    const int I_IN = (DM / 64) * (n_in / 32), I_OUT = (DM / 64) * (DM / 32), I_UP = (DM / 64) * (NU / 32), I_DN = (FF / 64) * (DM / 32);
    const int total = I_IN + I_OUT + I_UP + I_DN;
    for (int it = gw; it < total; it += ngw) {
        int r = it;
        if (r < I_IN) { if (odd) transpose_item<2>(w_in, DM, n_in, (bf16_t*)(ws + WS_WIN), scr, r, lane); else transpose_item<1>(w_in, DM, n_in, (bf16_t*)(ws + WS_WIN), scr, r, lane); continue; } r -= I_IN;
        if (r < I_OUT) { transpose_item<0>(w_out, DM, DM, (bf16_t*)(ws + WS_WOUT), scr, r, lane); continue; } r -= I_OUT;
        if (r < I_UP) { transpose_item<3>(w_up, DM, NU, (bf16_t*)(ws + WS_WUP), scr, r, lane); continue; } r -= I_UP;
        transpose_item<0>(w_dn, FF, DM, (bf16_t*)(ws + WS_WDN), scr, r, lane);
    }
}

__device__ __forceinline__ void phase_adaln(ArgsP a, LAS unsigned char* lds, int bid, int G, int tid, int wave, int lane) {
    LAS float* red = (LAS float*)(lds + 8 * 16384);
    const float* c = a->in[1]; const float* cc = a->in[3]; const float* ada_w = a->in[4]; const float* ada_b = a->in[5];
    float* mods = (float*)(a->ws + WS_MODS);
    for (int task = bid; task < 96; task += G) {
        const int l = task / 24, cgp = task % 24;
        const float* W = ada_w + (size_t)l * DM * NMOD + cgp * 256 + 4 * lane;
        f32x4 a0 = {0.f, 0.f, 0.f, 0.f}, a1 = {0.f, 0.f, 0.f, 0.f};
#pragma unroll 8
        for (int kk = 0; kk < 128; ++kk) { const int k = wave * 128 + kk; const float s0 = silu_f(c[k]), s1 = silu_f(cc[k]);
            const f32x4 w = *(const f32x4*)(W + (size_t)k * NMOD); a0 += w * s0; a1 += w * s1; }
#pragma unroll
        for (int j = 0; j < 4; ++j) { red[(wave * 2 + 0) * 256 + 4 * lane + j] = a0[j]; red[(wave * 2 + 1) * 256 + 4 * lane + j] = a1[j]; }
        __syncthreads();
        { const int v = tid >> 8, col = tid & 255; float s = 0.f;
#pragma unroll
          for (int w = 0; w < 8; ++w) s += red[(w * 2 + v) * 256 + col];
          mods[(size_t)(l * 2 + v) * NMOD + cgp * 256 + col] = s + ada_b[l * NMOD + cgp * 256 + col]; }
        __syncthreads();
    }
}
__device__ __forceinline__ void rope_tables(ArgsP a, int tid) {
    float* cosT = (float*)(a->ws + WS_ROPE); float* sinT = cosT + 4096;
    for (int idx = tid; idx < 4096; idx += 512) { const int pos = idx >> 4, i = idx & 15;
        const float f = exp2f(-(float)i * (13.287712379549449f / 16.0f)); const float ang = (float)pos * f;
        cosT[idx] = __cosf(ang); sinT[idx] = __sinf(ang); }
}
__device__ __forceinline__ void phase_init(ArgsP a, int gw, int ngw, int lane) {
    float* XS = (float*)(a->ws + WS_XS); bf16_t* XN = (bf16_t*)(a->ws + WS_XN); const float* mods = (const float*)(a->ws + WS_MODS);
    for (int r = gw; r < MT; r += ngw) {
        const bool isc = r >= S_LAT; const float* src = isc ? a->in[2] + (size_t)(r - S_LAT) * DM : a->in[0] + (size_t)r * DM;
        const float* mv = mods + (isc ? NMOD : 0);
#pragma unroll
        for (int j = 0; j < 4; ++j) { const int c0 = 4 * lane + 256 * j; const f32x4 x = *(const f32x4*)(src + c0), sh = *(const f32x4*)(mv + c0), sc = *(const f32x4*)(mv + DM + c0);
            *(f32x4*)(XS + (size_t)r * DM + c0) = x; const f32x4 h = x * (sc + 1.0f) + sh;
            u32x2 w; w.x = pk2(h[0], h[1]); w.y = pk2(h[2], h[3]); *(u32x2*)(XN + (size_t)r * DM + c0) = w; }
    }
}
__device__ __forceinline__ void phase_ln(ArgsP a, int nrows, const float* g, const float* b, const float* mod_lat  , float* dout, int gw, int ngw, int lane) {
    float* XS = (float*)(a->ws + WS_XS); bf16_t* XN = (bf16_t*)(a->ws + WS_XN);
    for (int r = gw; r < nrows; r += ngw) {
        const float* zr = XS + (size_t)r * DM;
        f32x4 v[4]; float s = 0.f;
#pragma unroll
        for (int j = 0; j < 4; ++j) { v[j] = *(const f32x4*)(zr + 4 * lane + 256 * j); s += (v[j][0] + v[j][1]) + (v[j][2] + v[j][3]); }
        const float mean = wave_sum(s) * (1.0f / DM); float s2 = 0.f;
#pragma unroll
        for (int j = 0; j < 4; ++j) { v[j] = v[j] - mean; s2 += (v[j][0] * v[j][0] + v[j][1] * v[j][1]) + (v[j][2] * v[j][2] + v[j][3] * v[j][3]); }
        const float rstd = 1.0f / sqrtf(wave_sum(s2) * (1.0f / DM) + LN_EPS);
        const float* mv = mod_lat ? mod_lat + (r >= S_LAT ? NMOD : 0) : nullptr;
#pragma unroll
        for (int j = 0; j < 4; ++j) { const int c0 = 4 * lane + 256 * j; const f32x4 x = v[j] * rstd * *(const f32x4*)(g + c0) + *(const f32x4*)(b + c0);
            if (dout) *(f32x4*)(dout + (size_t)r * DM + c0) = x;
            else { *(f32x4*)(XS + (size_t)r * DM + c0) = x;
                const f32x4 h = x * (*(const f32x4*)(mv + DM + c0) + 1.0f) + *(const f32x4*)(mv + c0);
                u32x2 w; w.x = pk2(h[0], h[1]); w.y = pk2(h[2], h[3]); *(u32x2*)(XN + (size_t)r * DM + c0) = w; } }
    }
}
__device__ __forceinline__ void unpack8(const u32x4 w, float (&f)[8]) { f[0] = bf_lo(w.x); f[1] = bf_hi(w.x); f[2] = bf_lo(w.y); f[3] = bf_hi(w.y); f[4] = bf_lo(w.z); f[5] = bf_hi(w.z); f[6] = bf_lo(w.w); f[7] = bf_hi(w.w); }
__device__ __forceinline__ void phase_conv(ArgsP a, int l, int nrows, int gtid, int ngt) {
    const bf16_t* U = (const bf16_t*)(a->ws + WS_R1); bf16_t* HF = (bf16_t*)(a->ws + WS_HF);
    const float* cw = a->in[17] + (size_t)l * 3 * NU; const float* cb = a->in[18] + (size_t)l * NU;
    const int nitems = (nrows / 8) * 352;
    for (int idx = gtid; idx < nitems; idx += ngt) {
        const int chunk = idx % 352, rb = idx / 352, row0 = rb * 8, c = chunk * 8;
        const int seg_lo = row0 < S_LAT ? 0 : S_LAT, seg_hi = row0 < S_LAT ? S_LAT : MT;
        const int ucol = 256 * (c >> 7) + (c & 127);
        float wa[3][8], wg[3][8], ba[8], bg[8];
#pragma unroll
        for (int j = 0; j < 3; ++j) {
#pragma unroll
            for (int e = 0; e < 8; e += 4) { const f32x4 x = *(const f32x4*)(cw + j * NU + c + e), y = *(const f32x4*)(cw + j * NU + FF + c + e);
                wa[j][e] = x[0]; wa[j][e + 1] = x[1]; wa[j][e + 2] = x[2]; wa[j][e + 3] = x[3]; wg[j][e] = y[0]; wg[j][e + 1] = y[1]; wg[j][e + 2] = y[2]; wg[j][e + 3] = y[3]; } }
#pragma unroll
        for (int e = 0; e < 8; e += 4) { const f32x4 x = *(const f32x4*)(cb + c + e), y = *(const f32x4*)(cb + FF + c + e);
            ba[e] = x[0]; ba[e + 1] = x[1]; ba[e + 2] = x[2]; ba[e + 3] = x[3]; bg[e] = y[0]; bg[e + 1] = y[1]; bg[e + 2] = y[2]; bg[e + 3] = y[3]; }
        const u32x4 zero = {0u, 0u, 0u, 0u};
        const bf16_t* up = U + (size_t)row0 * NU + ucol;
        u32x4 pa = zero, pg = zero, ca, cg_, na, ng;
        if (row0 - 1 >= seg_lo) { pa = *(const u32x4*)(up - NU); pg = *(const u32x4*)(up - NU + 128); }
        ca = *(const u32x4*)(up); cg_ = *(const u32x4*)(up + 128);
#pragma unroll
        for (int i = 0; i < 8; ++i) {
            const int row = row0 + i;
            if (row + 1 < seg_hi) { na = *(const u32x4*)(up + (size_t)(i + 1) * NU); ng = *(const u32x4*)(up + (size_t)(i + 1) * NU + 128); } else { na = zero; ng = zero; }
            float fpa[8], fca[8], fna[8], fpg[8], fcg[8], fng[8], h[8];
            unpack8(pa, fpa); unpack8(ca, fca); unpack8(na, fna); unpack8(pg, fpg); unpack8(cg_, fcg); unpack8(ng, fng);
#pragma unroll
            for (int e = 0; e < 8; ++e) { const float av = ba[e] + wa[0][e] * fpa[e] + wa[1][e] * fca[e] + wa[2][e] * fna[e]; const float gv = bg[e] + wg[0][e] * fpg[e] + wg[1][e] * fcg[e] + wg[2][e] * fng[e];
                h[e] = silu_f(gv) * av; }
            u32x4 o; o.x = pk2(h[0], h[1]); o.y = pk2(h[2], h[3]); o.z = pk2(h[4], h[5]); o.w = pk2(h[6], h[7]);
            *(u32x4*)(HF + (size_t)row * FF + c) = o;
            pa = ca; pg = cg_; ca = na; cg_ = ng;
        }
    }
}

typedef short v4i16_t __attribute__((ext_vector_type(4)));
template <int MODE>
__device__ __forceinline__ void wave_attn(const bf16_t* Q, const bf16_t* K, const bf16_t* V, bf16_t* O, int pitch, int qtok, int nloc, int kbase, int kstride,
                                          const LAS float* rpb, bool has_sink, float sink_l2, LAS unsigned char* vl, int lane) {
    const int r32 = lane & 31, hi = lane >> 5;
    bf16x8 qr[4];
    { const bf16_t* qp = Q + (size_t)qtok * pitch + 8 * hi;
#pragma unroll
      for (int d0 = 0; d0 < 4; ++d0) qr[d0] = *(const bf16x8*)(qp + 16 * d0); }
    float m = -1e30f, l = 0.f;
    f32x16 o0, o1;
#pragma unroll
    for (int r = 0; r < 16; ++r) { o0[r] = 0.f; o1[r] = 0.f; }
    const int ntile = nloc + 8;
    const int qrow = qtok >> 6, qcol = qtok & 63;
    const int rs_q = min(max(qrow - 4, 0), 248), cs_q = min(max(qcol - 8, 0), 48);
    bf16x8 kfn[4], vn[4];
    { const int kt = nloc > 0 ? kbase : S_LAT;
      const bf16_t* kp = K + (size_t)(kt + r32) * pitch + 8 * hi; const bf16_t* vp = V + (size_t)(kt + (lane >> 1)) * pitch + (lane & 1) * 32;
#pragma unroll
      for (int d0 = 0; d0 < 4; ++d0) { kfn[d0] = *(const bf16x8*)(kp + 16 * d0); vn[d0] = *(const bf16x8*)(vp + 8 * d0); } }
    const LAS unsigned char* vb = vl + (4 * hi + ((lane & 15) >> 2)) * 144 + ((lane >> 4) & 1) * 32 + (lane & 3) * 8;
    LAS unsigned char* vdst = vl + (lane >> 1) * 144 + (lane & 1) * 64;
    for (int u = 0; u < ntile; ++u) {
        bf16x8 kf[4], vr[4];
#pragma unroll
        for (int d0 = 0; d0 < 4; ++d0) { kf[d0] = kfn[d0]; vr[d0] = vn[d0]; }
        if (u + 1 < ntile) {
            const int kt = (u + 1 < nloc) ? kbase + kstride * (u + 1) : S_LAT + 32 * (u + 1 - nloc);
            const bf16_t* kp = K + (size_t)(kt + r32) * pitch + 8 * hi; const bf16_t* vp = V + (size_t)(kt + (lane >> 1)) * pitch + (lane & 1) * 32;
#pragma unroll
            for (int d0 = 0; d0 < 4; ++d0) { kfn[d0] = *(const bf16x8*)(kp + 16 * d0); vn[d0] = *(const bf16x8*)(vp + 8 * d0); }
        }
        asm volatile("" ::: "memory");
#pragma unroll
        for (int d0 = 0; d0 < 4; ++d0) *(LAS bf16x8*)(vdst + 16 * d0) = vr[d0];
        f32x16 s;
#pragma unroll
        for (int r = 0; r < 16; ++r) s[r] = 0.f;
#pragma unroll
        for (int d0 = 0; d0 < 4; ++d0) s = __builtin_amdgcn_mfma_f32_32x32x16_bf16(kf[d0], qr[d0], s, 0, 0, 0);
        if (MODE != 2 && u < nloc) {
            if (MODE == 0) {
                const int kr = (kbase >> 6) + u, c0 = kbase & 63;
                const bool rowok = (kr >= rs_q) && (kr < rs_q + 8);
                const int ib = (kr - qrow + 7) * 31 + (c0 - qcol + 15);
#pragma unroll
                for (int r = 0; r < 16; ++r) { const int kvl = (r & 3) + 8 * (r >> 2) + 4 * hi; const int kc = c0 + kvl;
                    const bool ok = rowok && (kc >= cs_q) && (kc < cs_q + 16);
                    const float bias = rpb[ok ? ib + kvl : 0];
                    s[r] = ok ? s[r] + bias : -1e30f; }
            } else {
                const int d0k = kbase + kstride * u - qtok;
#pragma unroll
                for (int r = 0; r < 16; ++r) { const int dd = d0k + (r & 3) + 8 * (r >> 2) + 4 * hi; s[r] = (dd >= -128 && dd <= 128) ? s[r] : -1e30f; }
            }
        }
        float tm = s[0];
#pragma unroll
        for (int r = 1; r < 16; ++r) tm = fmaxf(tm, s[r]);
        tm = fmaxf(tm, __shfl_xor(tm, 32));
        const float mn = fmaxf(m, tm), al = __builtin_amdgcn_exp2f(m - mn); m = mn;
        float rsum = 0.f;
#pragma unroll
        for (int r = 0; r < 16; ++r) { s[r] = __builtin_amdgcn_exp2f(s[r] - mn); rsum += s[r]; }
        l = l * al + rsum;
#pragma unroll
        for (int r = 0; r < 16; ++r) { o0[r] *= al; o1[r] *= al; }
        u32x4 w0, w1;
        w0.x = pk2(s[0], s[1]); w0.y = pk2(s[2], s[3]); w0.z = pk2(s[4], s[5]); w0.w = pk2(s[6], s[7]);
        w1.x = pk2(s[8], s[9]); w1.y = pk2(s[10], s[11]); w1.z = pk2(s[12], s[13]); w1.w = pk2(s[14], s[15]);
        const bf16x8 pf0 = __builtin_bit_cast(bf16x8, w0), pf1 = __builtin_bit_cast(bf16x8, w1);
        asm volatile("s_waitcnt lgkmcnt(0)" ::: "memory");
#pragma unroll
        for (int s2 = 0; s2 < 2; ++s2) {
#pragma unroll
            for (int d0 = 0; d0 < 2; ++d0) {
                const s16x4 lo = __builtin_bit_cast(s16x4, __builtin_amdgcn_ds_read_tr16_b64_v4i16((LAS v4i16_t*)(vb + (16 * s2) * 144 + d0 * 64)));
                const s16x4 hh = __builtin_bit_cast(s16x4, __builtin_amdgcn_ds_read_tr16_b64_v4i16((LAS v4i16_t*)(vb + (16 * s2 + 8) * 144 + d0 * 64)));
                const bf16x8 vf = {lo[0], lo[1], lo[2], lo[3], hh[0], hh[1], hh[2], hh[3]};
                if (d0 == 0) o0 = __builtin_amdgcn_mfma_f32_32x32x16_bf16(vf, s2 ? pf1 : pf0, o0, 0, 0, 0);
                else         o1 = __builtin_amdgcn_mfma_f32_32x32x16_bf16(vf, s2 ? pf1 : pf0, o1, 0, 0, 0);
            }
        }
        asm volatile("s_waitcnt lgkmcnt(0)" ::: "memory");
    }
    if (has_sink) { const float mn = fmaxf(m, sink_l2), al = __builtin_amdgcn_exp2f(m - mn); l = l * al + (hi == 0 ? __builtin_amdgcn_exp2f(sink_l2 - mn) : 0.f);
#pragma unroll
        for (int r = 0; r < 16; ++r) { o0[r] *= al; o1[r] *= al; } }
    l += __shfl_xor(l, 32);
    const float inv = 1.0f / l;
    bf16_t* op = O + (size_t)qtok * DM + 4 * hi;
#pragma unroll
    for (int g = 0; g < 4; ++g) {
        u32x2 wa, wb; wa.x = pk2(o0[4 * g] * inv, o0[4 * g + 1] * inv); wa.y = pk2(o0[4 * g + 2] * inv, o0[4 * g + 3] * inv);
        wb.x = pk2(o1[4 * g] * inv, o1[4 * g + 1] * inv); wb.y = pk2(o1[4 * g + 2] * inv, o1[4 * g + 3] * inv);
        *(u32x2*)(op + 8 * g) = wa; *(u32x2*)(op + 32 + 8 * g) = wb;
    }
}
__device__ __forceinline__ void phase_attn_waves(ArgsP a, int l, bool ctx_out, LAS unsigned char* lds, int gw, int ngw, int wave, int lane) {
    const bool odd = l & 1; const int li = l >> 1;
    const bf16_t* QKV = (const bf16_t*)(a->ws + WS_R1); bf16_t* OB = (bf16_t*)(a->ws + WS_O);
    const LAS float* rpbL = (const LAS float*)lds;
    LAS unsigned char* vl = lds + 16384 + wave * 4608;
    const int r32 = lane & 31;
    const int nmain = odd ? 8192 : 4096, total = nmain + (ctx_out ? 128 : 0);
    for (int idx = gw; idx < total; idx += ngw) {
        if (idx < nmain) {
            const int h = idx >> 9, qt = idx & 511;
            if (!odd) {
                const int rp = qt >> 2, cb = qt & 3;
                const int R0 = min(max(2 * rp - 4, 0), 247), C0 = min(max(16 * cb - 8, 0), 32);
                const int qtok = (2 * rp + (r32 >> 4)) * 64 + 16 * cb + (r32 & 15);
                wave_attn<0>(QKV + 768 + h * 64, QKV + 1280 + h * 64, QKV + 1792 + h * 64, OB + 512 + h * 64, N_EVEN, qtok, 9, R0 * 64 + C0, 64, rpbL + h * 465, false, 0.f, vl, lane);
            } else {
                const int ulo = max(0, 4 - qt), uhi = min(8, 515 - qt);
                const float sk = a->in[15][li * 16 + h] * LOG2E;
                wave_attn<1>(QKV + h * 64, QKV + 1024 + (h >> 3) * 64, QKV + 1152 + (h >> 3) * 64, OB + h * 64, N_ODD, 32 * qt + r32, uhi - ulo + 1, 32 * qt - 128 + 32 * ulo, 32, rpbL, true, sk, vl, lane);
            }
        } else {
            const int j = idx - nmain, h = (j >> 3) & (odd ? 15 : 7), qt = j & 7; const int qtok = S_LAT + 32 * qt + r32;
            const bf16_t *q, *k, *v; bf16_t* o; bool sink = false; float sk = 0.f;
            if (odd) { q = QKV + h * 64; k = QKV + 1024 + (h >> 3) * 64; v = QKV + 1152 + (h >> 3) * 64; o = OB + h * 64; sink = true; sk = a->in[15][li * 16 + h] * LOG2E; }
            else if (j < 64) { q = QKV + h * 64; k = QKV + 512 + (h >> 2) * 64; v = QKV + 640 + (h >> 2) * 64; o = OB + h * 64; }
            else { q = QKV + 768 + h * 64; k = QKV + 1280 + h * 64; v = QKV + 1792 + h * 64; o = OB + 512 + h * 64; }
            wave_attn<2>(q, k, v, o, odd ? N_ODD : N_EVEN, qtok, 0, 0, 0, rpbL, sink, sk, vl, lane);
        }
    }
}

#define FRESH_IDS() int tid = threadIdx.x; asm volatile("" : "+v"(tid)); const int lane = tid & 63, wave = __builtin_amdgcn_readfirstlane(tid >> 6); const int gw = bid * 8 + wave, ngw = G * 8; (void)lane; (void)gw; (void)ngw
#define GRID_BAR() do { int tid_b = threadIdx.x; asm volatile("" : "+v"(tid_b)); XcdBarrier xb_; xb_.bar = (unsigned*)(relaunder(ap)->ws + WS_BAR); xb_.x = xb_xcc_id(); xb_.st = (volatile LAS unsigned*)((LAS unsigned char*)lds_raw + LDS_BARST); xcd_barrier(xb_, tid_b); } while (0)
template <int L> __device__ __forceinline__ void run_layer(ArgsP ap, unsigned char* lds_raw, float* dout_unused) {
    constexpr int l = L; constexpr bool odd = (L & 1) != 0, ctx_out = L < 3; constexpr int li = L >> 1;
    constexpr int n_in = odd ? N_ODD : N_EVEN, m_rows = ctx_out ? MT : S_LAT;
    LAS unsigned char* lds = (LAS unsigned char*)lds_raw;
    const int G = gridDim.x, bid = blockIdx.x;
    {
        ArgsP a = relaunder(ap); unsigned char* ws = a->ws; const float* cosT = (const float*)(ws + WS_ROPE);
        pg8::Gemm g{(const bf16_t*)(ws + WS_XN), (const bf16_t*)(ws + WS_WIN), MT, n_in, DM}; pg8::StaticOrder S; S.init(MT, n_in, G, bid);
        pg8::EpiInproj E{(bf16_t*)(ws + WS_R1), n_in, a->in[10] + li * 64, a->in[11] + li * 64, cosT, cosT + 4096, odd ? 0 : 512, odd ? 0 : 640, odd ? 1152 : 640, odd ? 1024 : 512, odd ? 0 : 768, odd ? 0 : 1280, QC2};
        pg8::gemm_phase<pg8::EpiInproj, pg8::StaticOrder, true, true>(lds, g, S, E);
    }
    GRID_BAR();
    if (!odd) {
        FRESH_IDS(); ArgsP a = relaunder(ap); unsigned char* ws = a->ws; const bf16_t* QKV = (const bf16_t*)(ws + WS_R1); bf16_t* OB = (bf16_t*)(ws + WS_O);
        const int vcu = (G % 8 == 0) ? (bid % 8) * (G / 8) + bid / 8 : bid;
        for (int unit = vcu; unit < 512; unit += G) { const int h = unit >> 6, qb = unit & 63;
            attn_body::attn_unit<8>(qb, (const attn_body::bf16*)(QKV + h * 64), (const attn_body::bf16*)(QKV + 512 + (h >> 2) * 64), (const attn_body::bf16*)(QKV + 640 + (h >> 2) * 64),
                                    (attn_body::bf16*)(OB + h * 64), (char*)lds_raw); }
        __syncthreads();
        { const float* rpb = a->in[12] + (size_t)li * 8 * 465; LAS float* rl = (LAS float*)lds;
          for (int i = tid; i < 8 * 465; i += 512) rl[i] = rpb[i] * LOG2E; }
        __syncthreads();
    }
    { FRESH_IDS(); phase_attn_waves(relaunder(ap), l, ctx_out, lds, gw, ngw, wave, lane); }
    GRID_BAR();
    {
        ArgsP a = relaunder(ap); unsigned char* ws = a->ws; const float* ml = (const float*)(ws + WS_MODS) + (size_t)(l * 2) * NMOD;
        pg8::Gemm g{(const bf16_t*)(ws + WS_O), (const bf16_t*)(ws + WS_WOUT), m_rows, DM, DM}; pg8::StaticOrder S; S.init(m_rows, DM, G, bid);
        pg8::EpiResid E{(float*)(ws + WS_XS), ml + 2 * DM, ml + NMOD + 2 * DM, DN_ALPHA};
        pg8::gemm_phase<pg8::EpiResid, pg8::StaticOrder, true, true>(lds, g, S, E);
    }
    GRID_BAR();
    { FRESH_IDS(); ArgsP a = relaunder(ap); const float* ml = (const float*)(a->ws + WS_MODS) + (size_t)(l * 2) * NMOD;
      phase_ln(a, m_rows, a->in[6] + (size_t)(l * 2) * DM, a->in[7] + (size_t)(l * 2) * DM, ml + 3 * DM, nullptr, gw, ngw, lane); }
    GRID_BAR();
    {
        ArgsP a = relaunder(ap); unsigned char* ws = a->ws;
        pg8::Gemm g{(const bf16_t*)(ws + WS_XN), (const bf16_t*)(ws + WS_WUP), m_rows, NU, DM}; pg8::StaticOrder S; S.init(m_rows, NU, G, bid);
        pg8::EpiStore E{(bf16_t*)(ws + WS_R1), NU};
        pg8::gemm_phase<pg8::EpiStore, pg8::StaticOrder, true, true>(lds, g, S, E);
    }
    GRID_BAR();
    { FRESH_IDS(); phase_conv(relaunder(ap), l, m_rows, bid * 512 + tid, G * 512); }
    GRID_BAR();
    {
        ArgsP a = relaunder(ap); unsigned char* ws = a->ws; const float* ml = (const float*)(ws + WS_MODS) + (size_t)(l * 2) * NMOD;
        pg8::Gemm g{(const bf16_t*)(ws + WS_HF), (const bf16_t*)(ws + WS_WDN), m_rows, DM, FF}; pg8::StaticOrder S; S.init(m_rows, DM, G, bid);
        pg8::EpiResid E{(float*)(ws + WS_XS), ml + 5 * DM, ml + NMOD + 5 * DM, DN_ALPHA};
        pg8::gemm_phase<pg8::EpiResid, pg8::StaticOrder, true, true>(lds, g, S, E);
    }
    GRID_BAR();
    { FRESH_IDS(); ArgsP a = relaunder(ap);
      if (l < 3) { phase_ln(a, m_rows, a->in[6] + (size_t)(l * 2 + 1) * DM, a->in[7] + (size_t)(l * 2 + 1) * DM, (const float*)(a->ws + WS_MODS) + (size_t)((l + 1) * 2) * NMOD, nullptr, gw, ngw, lane);
                   convert_layer(relaunder(ap), l + 1, lds, gw, ngw, wave, lane); GRID_BAR(); }
      else phase_ln(a, S_LAT, a->in[6] + (size_t)(l * 2 + 1) * DM, a->in[7] + (size_t)(l * 2 + 1) * DM, nullptr, a->out, gw, ngw, lane); }
}

__global__ void __launch_bounds__(512, 2) mk_fwd(Args a_by_value) {
    extern __shared__ __attribute__((aligned(16))) unsigned char lds_raw[];
    cg::grid_group grid = cg::this_grid();
    const ArgsP ap = (ArgsP)__builtin_amdgcn_kernarg_segment_ptr();
    {
        LAS unsigned char* lds = (LAS unsigned char*)lds_raw;
        const int tid = threadIdx.x, lane = tid & 63, wave = __builtin_amdgcn_readfirstlane(tid >> 6);
        const int G = gridDim.x, bid = blockIdx.x, gw = bid * 8 + wave, ngw = G * 8;
        if (tid < 16) ((LAS unsigned*)(lds + LDS_BARST))[tid] = 0u;
        __syncthreads();
        (void)xcd_barrier_post((unsigned*)(relaunder(ap)->ws + WS_BAR), (volatile LAS unsigned*)(lds + LDS_BARST), tid);
        phase_adaln(relaunder(ap), lds, bid, G, tid, wave, lane);
        if (bid == G - 1) rope_tables(relaunder(ap), tid);
        convert_layer(relaunder(ap), 0, lds, gw, ngw, wave, lane);
        grid.sync();
        phase_init(relaunder(ap), gw, ngw, lane);
        GRID_BAR();
    }
    run_layer<0>(ap, lds_raw, nullptr);
    run_layer<1>(ap, lds_raw, nullptr);
    run_layer<2>(ap, lds_raw, nullptr);
    run_layer<3>(ap, lds_raw, nullptr);
}

extern "C" void kernel_launch(void* const* d_in, const int* in_sizes, int n_in, void* d_out, int out_size, void* d_ws, size_t ws_size, hipStream_t stream) {
    static int grid = 0;
    if (grid == 0) {
        if (n_in != 20 || out_size != S_LAT * DM || ws_size < WS_END) { fprintf(stderr, "kernel_launch: unexpected problem (n_in %d, out %d, ws %zu < %zu)\n", n_in, out_size, ws_size, (size_t)WS_END); grid = -1; return; }
        int dev = 0, cus = 0, per_cu = 0;
        (void)hipGetDevice(&dev); (void)hipDeviceGetAttribute(&cus, hipDeviceAttributeMultiprocessorCount, dev);
        if (hipFuncSetAttribute((const void*)mk_fwd, hipFuncAttributeMaxDynamicSharedMemorySize, LDS_BYTES) != hipSuccess) { fprintf(stderr, "kernel_launch: hipFuncSetAttribute failed\n"); grid = -1; return; }
        if (hipOccupancyMaxActiveBlocksPerMultiprocessor(&per_cu, (const void*)mk_fwd, 512, LDS_BYTES) != hipSuccess || per_cu < 1) { fprintf(stderr, "kernel_launch: occupancy query says %d\n", per_cu); per_cu = 1; }
        (void)hipGetLastError();
        grid = cus * 1;
        if (grid <= 0) grid = 256;
    }
    if (grid < 0) return;
    Args a{};
    for (int i = 0; i < 20; ++i) a.in[i] = (const float*)d_in[i];
    a.out = (float*)d_out; a.ws = (unsigned char*)d_ws;
    if (hipMemsetAsync((char*)d_ws + WS_BAR, 0, 16384, stream) != hipSuccess) { fprintf(stderr, "kernel_launch: memset failed\n"); return; }
    void* args[] = {&a};
    hipError_t e = hipLaunchCooperativeKernel((const void*)mk_fwd, dim3(grid), dim3(512), args, LDS_BYTES, stream);
    if (e != hipSuccess) fprintf(stderr, "cooperative launch failed: %s (grid %d)\n", hipGetErrorString(e), grid);
}
```

```cpp
#include <hip/hip_runtime.h>
#include <hip/hip_cooperative_groups.h>
#include <hip/hip_bf16.h>
#include <cstdio>
#include <cstdint>
#include <cmath>
namespace cg = cooperative_groups;
namespace pg8 {
#define PG8_LAS __attribute__((address_space(3)))
typedef unsigned short bf16_t;
typedef short bf16x8 __attribute__((ext_vector_type(8)));
typedef float f32x4 __attribute__((ext_vector_type(4)));
typedef unsigned u32x4 __attribute__((ext_vector_type(4)));
constexpr int BM = 256, BK = 64, HALF = 128, HTB = HALF * BK * 2  , STAGE_BYTES = 8 * HTB, NXCD = 8, WGM = 8;

__host__ __device__ __forceinline__ int lds_byte(int r, int c) { const int st = (r >> 4) * 2 + (c >> 5), rr = r & 15, cc = c & 31, ob = rr * 64 + cc * 2; return st * 1024 + (ob ^ (((ob >> 9) & 1) << 5)); }
__host__ __device__ __forceinline__ void stage_rc(int b, int& R, int& C) { const int st = b / 1024, sb = b % 1024, swz = sb ^ (((sb >> 9) & 1) << 5); R = (st >> 1) * 16 + swz / 64; C = (st & 1) * 32 + (swz % 64) / 2; }
__host__ __device__ __forceinline__ int perm32(int rho) { const int n = rho >> 4, i = rho & 15; return 8 * (i >> 2) + 4 * n + (i & 3); }

struct Unit { int pm, pn, arow, ko; };
struct Gemm { const bf16_t* A; const bf16_t* Bt; int M, N, K, ldk; };

struct StaticOrder {
    int nM, nN, nwg, G, c;
    __host__ __device__ void init(int M, int N, int G_, int c_) { nM = M / BM; nN = N / BM; nwg = nM * nN; G = G_; c = c_; }
    __host__ __device__ bool next(int i, Unit& u) const {
        const long L = (long)i * G + c; if (L >= nwg) return false;
        int wgid = (int)L; { const int q = nwg / NXCD, r = nwg % NXCD, xcd = wgid % NXCD, off = wgid / NXCD; wgid = (xcd < r ? xcd * (q + 1) : r * (q + 1) + (xcd - r) * q) + off; }
        const int nig = WGM * nN, gid = wgid / nig, fm = gid * WGM, gsz = (nM - fm) < WGM ? (nM - fm) : WGM;
        u.pm = fm + ((wgid % nig) % gsz); u.pn = (wgid % nig) / gsz; u.arow = u.pm * BM; u.ko = 0; return true;
    }
    __device__ __forceinline__ void a_ready(const Unit&) const {}
    __device__ __forceinline__ void done(const Unit&) const {}
};

template <int NN, int NKC, int KCHUNK, int PM_LABEL> struct SplitKOrder {
    int G, c;
    __host__ __device__ void init(int G_, int c_) { G = G_; c = c_; }
    __host__ __device__ bool next(int i, Unit& u) const { const int L = i * G + c; if (L >= NN * NKC) return false; u.pm = PM_LABEL; u.pn = L % NN; u.arow = 0; u.ko = (L / NN) * KCHUNK; return true; }
    __device__ __forceinline__ void a_ready(const Unit&) const {}
    __device__ __forceinline__ void done(const Unit&) const {}
};
__device__ __forceinline__ unsigned cvt_pk_bf16(float lo, float hi) { unsigned r; asm volatile("v_cvt_pk_bf16_f32 %0, %1, %2" : "=v"(r) : "v"(lo), "v"(hi)); return r; }
typedef float f32x2 __attribute__((ext_vector_type(2)));
__device__ __forceinline__ unsigned pk_bf16(float lo, float hi) { typedef float f2 __attribute__((ext_vector_type(2))); typedef __bf16 b2 __attribute__((ext_vector_type(2))); f2 v = {lo, hi}; b2 b = __builtin_convertvector(v, b2); return __builtin_bit_cast(unsigned, b); }

struct EpiInproj {
    static constexpr bool PERM = true, AFTER_DRAIN = false;
    bf16_t* O; int ldc;
    const float* qg; const float* kg;
    const float* cosT; const float* sinT;
    int rmsq_end, rms_end, rope_end, sc1_end, sc2_beg, sc2_end;
    float c2;
    __device__ __forceinline__ void operator()(const f32x4 (&acc)[2][2][4][2], const Unit& u, int wr, int wc, int fr, int fq) const {
        const int hb = u.pn * BM + wc * 64;
        const bool do_rms = hb < rms_end, do_rope = hb < rope_end;
        const float sc = (hb < sc1_end || (hb >= sc2_beg && hb < sc2_end)) ? c2 : 1.f;
        f32x4 gv[2][2];
#pragma unroll
        for (int bj = 0; bj < 2; ++bj)
#pragma unroll
            for (int n = 0; n < 2; ++n) gv[bj][n] = do_rms ? *(const f32x4*)((hb < rmsq_end ? qg : kg) + 32 * bj + 16 * n + 4 * fq) : (f32x4){1.f, 1.f, 1.f, 1.f};
#pragma unroll
        for (int ai = 0; ai < 2; ++ai)
#pragma unroll
            for (int m = 0; m < 4; ++m) {
                const int row = u.pm * BM + ai * HALF + wr * 64 + m * 16 + fr;
                f32x4 v[2][2];
#pragma unroll
                for (int bj = 0; bj < 2; ++bj)
#pragma unroll
                    for (int n = 0; n < 2; ++n) v[bj][n] = acc[ai][bj][m][n];
                if (do_rms) {
                    float ss = 0.f;
#pragma unroll
                    for (int bj = 0; bj < 2; ++bj)
#pragma unroll
                        for (int n = 0; n < 2; ++n) { const f32x4 x = v[bj][n]; ss += (x[0] * x[0] + x[1] * x[1]) + (x[2] * x[2] + x[3] * x[3]); }
                    ss += __shfl_xor(ss, 16); ss += __shfl_xor(ss, 32);
                    const float rinv = 1.0f / sqrtf(ss * (1.0f / 64.0f) + 1e-6f);
#pragma unroll
                    for (int bj = 0; bj < 2; ++bj)
#pragma unroll
                        for (int n = 0; n < 2; ++n) v[bj][n] = v[bj][n] * rinv * gv[bj][n];
                }
                if (do_rope && row < 16384) {
#pragma unroll
                    for (int bj = 0; bj < 2; ++bj) {
                        const int pos = bj ? (row & 63) : (row >> 6);
                        const f32x4 cs = *(const f32x4*)(cosT + pos * 16 + 4 * fq), sn = *(const f32x4*)(sinT + pos * 16 + 4 * fq);
                        const f32x4 x1 = v[bj][0], x2 = v[bj][1];
                        v[bj][0] = x1 * cs - x2 * sn; v[bj][1] = x2 * cs + x1 * sn;
                    }
                }
                bf16_t* rowp = O + (size_t)row * ldc + hb + 8 * fq;
#pragma unroll
                for (int bj = 0; bj < 2; ++bj) {
                    const f32x4 a = v[bj][0] * sc, b = v[bj][1] * sc;
                    u32x4 w; w.x = pk_bf16(a[0], a[1]); w.y = pk_bf16(a[2], a[3]); w.z = pk_bf16(b[0], b[1]); w.w = pk_bf16(b[2], b[3]);
                    *(u32x4*)(rowp + 32 * bj) = w;
                }
                asm volatile("" ::: "memory");
            }
    }
};
template <bool ATOMIC> struct EpiResid {
    static constexpr bool PERM = true, AFTER_DRAIN = false;
    float* XS; const float* gate_lat; const float* gate_ctx; float* PART;
    __device__ __forceinline__ void operator()(const f32x4 (&acc)[2][2][4][2], const Unit& u, int wr, int wc, int fr, int fq) const {
        asm volatile("" : "+v"(fr));
        int pm = u.pm; asm volatile("" : "+s"(pm));
        const float* gate = (pm >= 64) ? gate_ctx : gate_lat;
        const int col0 = u.pn * BM + wc * 32 + 8 * fq;
        f32x4 gv[2][2];
#pragma unroll
        for (int bj = 0; bj < 2; ++bj)
#pragma unroll
            for (int n = 0; n < 2; ++n) gv[bj][n] = ATOMIC ? (f32x4){1.f, 1.f, 1.f, 1.f} : *(const f32x4*)(gate + col0 + bj * HALF + 4 * n);
#pragma unroll
        for (int ai = 0; ai < 2; ++ai)
#pragma unroll
            for (int m = 0; m < 4; ++m) {
                float* rowp = XS + (size_t)(pm * BM + ai * HALF + wr * 64 + m * 16 + fr) * 1024 + col0;
#pragma unroll
                for (int bj = 0; bj < 2; ++bj)
#pragma unroll
                    for (int n = 0; n < 2; ++n) {
                        const f32x4 d = gv[bj][n] * acc[ai][bj][m][n];
                        if (ATOMIC) { *(f32x4*)(PART + ((size_t)(u.ko >> 8) * 256 + (pm - 64) * BM + (ai * HALF + wr * 64 + m * 16 + fr)) * 1024 + col0 + bj * HALF + 4 * n) = d; }
                        else { f32x4* p = (f32x4*)(rowp + bj * HALF + 4 * n); const f32x4 x = *p; *p = x + d; }
                    }
                if (m & 1) asm volatile("" ::: "memory");
            }
    }
};
struct EpiStore {
    static constexpr bool PERM = true, AFTER_DRAIN = false;
    bf16_t* O; int ldc;
    __device__ __forceinline__ void operator()(const f32x4 (&acc)[2][2][4][2], const Unit& u, int wr, int wc, int fr, int fq) const {
        const int col0 = u.pn * BM + wc * 32 + 8 * fq;
#pragma unroll
        for (int ai = 0; ai < 2; ++ai)
#pragma unroll
            for (int m = 0; m < 4; ++m) {
                bf16_t* rowp = O + (size_t)(u.pm * BM + ai * HALF + wr * 64 + m * 16 + fr) * ldc + col0;
#pragma unroll
                for (int bj = 0; bj < 2; ++bj) { const f32x4 a = acc[ai][bj][m][0], b = acc[ai][bj][m][1];
                    u32x4 w; w.x = pk_bf16(a[0], a[1]); w.y = pk_bf16(a[2], a[3]); w.z = pk_bf16(b[0], b[1]); w.w = pk_bf16(b[2], b[3]);
                    *(u32x4*)(rowp + bj * HALF) = w; }
            }
    }
};
template <class Epi, class Sched, bool ALIGN_EPI = false, bool SP2 = false>
__device__ __forceinline__ void gemm_phase(PG8_LAS unsigned char* lds, const Gemm g, const Sched& S, const Epi& E) {
    int tid = threadIdx.x; asm volatile("" : "+v"(tid));
    const int wid = __builtin_amdgcn_readfirstlane(tid >> 6), lane = tid & 63, wr = wid >> 2, wc = wid & 3, fr = lane & 15, fq = lane >> 4;
    const int K = g.ldk, nt = g.K / BK;
    unsigned voffA[2], voffB[2];
#pragma unroll
    for (int i = 0; i < 2; ++i) { int R, C; stage_rc(tid * 16 + i * 8192, R, C); const int Rb = Epi::PERM ? ((R & ~31) + perm32(R & 31)) : R;
        voffA[i] = (unsigned)(R * K + C) * 2u; voffB[i] = (unsigned)(Rb * K + C) * 2u; }
    const size_t kstep = (size_t)(BK * 2);
    const size_t hstep = (size_t)HALF * K * 2;
    const size_t tstep = 2 * hstep;
    const unsigned ldsw = (unsigned)wid * 1024u;
    const int aoff = lds_byte(wr * 64 + fr, fq * 8), boff = lds_byte(wc * 32 + fr, fq * 8);
#define PG8_SA(b, h) (((b) * 2 + (h)) * HTB)
#define PG8_SB(b, h) ((4 + (b) * 2 + (h)) * HTB)
#define PG8_STAGE(bufoff, gbase, voff) do { _Pragma("unroll") for (int _i = 0; _i < 2; ++_i) \
        __builtin_amdgcn_global_load_lds((const unsigned*)((const char*)(gbase) + (voff)[_i]), (PG8_LAS unsigned*)(lds + (bufoff) + ldsw + _i * 8192), 16, 0, 0); } while (0)
#define PG8_LDA(dst, b, h) do { _Pragma("unroll") for (int m = 0; m < 4; ++m) _Pragma("unroll") for (int k = 0; k < 2; ++k) dst[m][k] = *(const PG8_LAS bf16x8*)(lds + PG8_SA(b, h) + aoff + m * 2048 + k * 1024); } while (0)
#define PG8_LDB(dst, b, h) do { _Pragma("unroll") for (int n = 0; n < 2; ++n) _Pragma("unroll") for (int k = 0; k < 2; ++k) dst[n][k] = *(const PG8_LAS bf16x8*)(lds + PG8_SB(b, h) + boff + n * 2048 + k * 1024); } while (0)
#define PG8_MMA(ai, bj, At, Bt) do { __builtin_amdgcn_s_setprio(1); _Pragma("unroll") for (int m = 0; m < 4; ++m) _Pragma("unroll") for (int n = 0; n < 2; ++n) _Pragma("unroll") for (int k = 0; k < 2; ++k) \
        acc[ai][bj][m][n] = __builtin_amdgcn_mfma_f32_16x16x32_bf16(Bt[n][k], At[m][k], acc[ai][bj][m][n], 0, 0, 0); __builtin_amdgcn_s_setprio(0); } while (0)
#define PG8_WAIT_V(n) asm volatile("s_waitcnt vmcnt(" #n ")" ::: "memory")
#define PG8_WAIT_L(n) asm volatile("s_waitcnt lgkmcnt(" #n ")" ::: "memory")
#define PG8_BAR __builtin_amdgcn_s_barrier()
#define PG8_SCHED __builtin_amdgcn_sched_barrier(0)
    Unit cur, nxt; int ui = 0;
    if (!S.next(0, cur)) return;
    f32x4 acc[2][2][4][2];
#pragma unroll
    for (int a = 0; a < 2; ++a)
#pragma unroll
        for (int b = 0; b < 2; ++b)
#pragma unroll
            for (int m = 0; m < 4; ++m)
#pragma unroll
                for (int n = 0; n < 2; ++n) acc[a][b][m][n] = (f32x4){0.f, 0.f, 0.f, 0.f};
    bf16x8 At[4][2], B0[2][2], B1[2][2];
    const char* cA = (const char*)g.A + ((long)cur.arow * K + cur.ko) * 2; const char* cB = (const char*)g.Bt + (size_t)cur.pn * tstep + (size_t)cur.ko * 2;
    S.a_ready(cur);
    if constexpr (SP2) {
        PG8_STAGE(PG8_SB(0, 0), cB, voffB); PG8_STAGE(PG8_SB(0, 1), cB + hstep, voffB); PG8_STAGE(PG8_SA(0, 0), cA, voffA); PG8_STAGE(PG8_SA(0, 1), cA + hstep, voffA);
        if (wr == 1) PG8_BAR;
        PG8_WAIT_V(2); PG8_BAR;
        PG8_STAGE(PG8_SB(1, 0), cB + kstep, voffB); PG8_STAGE(PG8_SA(1, 0), cA + kstep, voffA); PG8_STAGE(PG8_SB(1, 1), cB + hstep + kstep, voffB);
        PG8_WAIT_V(6); PG8_BAR;
    } else {
        PG8_STAGE(PG8_SB(0, 0), cB, voffB); PG8_STAGE(PG8_SA(0, 0), cA, voffA); PG8_STAGE(PG8_SB(0, 1), cB + hstep, voffB); PG8_STAGE(PG8_SA(0, 1), cA + hstep, voffA);
        if (wr == 1) PG8_BAR;
        PG8_WAIT_V(4); PG8_BAR;
        PG8_STAGE(PG8_SB(1, 0), cB + kstep, voffB); PG8_STAGE(PG8_SA(1, 0), cA + kstep, voffA); PG8_STAGE(PG8_SB(1, 1), cB + hstep + kstep, voffB);
        PG8_WAIT_V(6); PG8_BAR;
    }
    for (;;) {
        const bool has_next = S.next(ui + 1, nxt);
        const char* nA = has_next ? (const char*)g.A + ((long)nxt.arow * K + nxt.ko) * 2 : cA; const char* nB = has_next ? (const char*)g.Bt + (size_t)nxt.pn * tstep + (size_t)nxt.ko * 2 : cB;
        for (int t = 0; t < nt; t += 2) {
            const bool last = (t == nt - 2);
            const char* a1 = cA + (size_t)(t + 1) * kstep;
            const char* a2 = last ? nA : cA + (size_t)(t + 2) * kstep; const char* b2 = last ? nB : cB + (size_t)(t + 2) * kstep;
            const char* a3 = a2 + kstep; const char* b3 = b2 + kstep;
            if (last && has_next) S.a_ready(nxt);
            if constexpr (SP2) {
            PG8_LDB(B0, 0, 0); PG8_LDB(B1, 0, 1); PG8_SCHED; PG8_LDA(At, 0, 0); PG8_STAGE(PG8_SA(1, 1), a1 + hstep, voffA);
            PG8_WAIT_V(8); PG8_WAIT_L(0); PG8_BAR; PG8_MMA(0, 0, At, B0); PG8_MMA(0, 1, At, B1); PG8_BAR; PG8_SCHED;
            PG8_LDA(At, 0, 1); PG8_STAGE(PG8_SB(0, 0), b2, voffB); PG8_STAGE(PG8_SB(0, 1), b2 + hstep, voffB); PG8_STAGE(PG8_SA(0, 0), a2, voffA);
            PG8_WAIT_V(8); PG8_WAIT_L(0); PG8_BAR; PG8_MMA(1, 0, At, B0); PG8_MMA(1, 1, At, B1); PG8_BAR; PG8_SCHED;
            PG8_LDB(B0, 1, 0); PG8_LDB(B1, 1, 1); PG8_SCHED; PG8_LDA(At, 1, 0); PG8_STAGE(PG8_SA(0, 1), a2 + hstep, voffA);
            PG8_WAIT_V(8); PG8_WAIT_L(0); PG8_BAR; PG8_MMA(0, 0, At, B0); PG8_MMA(0, 1, At, B1); PG8_BAR; PG8_SCHED;
            PG8_LDA(At, 1, 1); PG8_STAGE(PG8_SB(1, 0), b3, voffB); PG8_STAGE(PG8_SB(1, 1), b3 + hstep, voffB); PG8_STAGE(PG8_SA(1, 0), a3, voffA);
            PG8_WAIT_V(8); PG8_WAIT_L(0); PG8_BAR; PG8_MMA(1, 0, At, B0); PG8_MMA(1, 1, At, B1); PG8_BAR; PG8_SCHED;
            } else {
            PG8_LDB(B0, 0, 0); PG8_SCHED; PG8_LDA(At, 0, 0); PG8_STAGE(PG8_SA(1, 1), a1 + hstep, voffA);
            PG8_WAIT_L(8); PG8_BAR; PG8_WAIT_L(0); PG8_MMA(0, 0, At, B0); PG8_BAR; PG8_SCHED;
            PG8_LDB(B1, 0, 1); PG8_STAGE(PG8_SB(0, 0), b2, voffB);
            PG8_BAR; PG8_WAIT_L(0); PG8_MMA(0, 1, At, B1); PG8_BAR;
            PG8_LDA(At, 0, 1); PG8_STAGE(PG8_SA(0, 0), a2, voffA);
            PG8_BAR; PG8_WAIT_L(0); PG8_MMA(1, 0, At, B0); PG8_BAR; PG8_SCHED;
            PG8_STAGE(PG8_SB(0, 1), b2 + hstep, voffB);
            PG8_WAIT_V(6); PG8_BAR; PG8_MMA(1, 1, At, B1); PG8_BAR;
            PG8_LDB(B0, 1, 0); PG8_SCHED; PG8_LDA(At, 1, 0); PG8_STAGE(PG8_SA(0, 1), a2 + hstep, voffA);
            PG8_WAIT_L(8); PG8_BAR; PG8_WAIT_L(0); PG8_MMA(0, 0, At, B0); PG8_BAR; PG8_SCHED;
            PG8_LDB(B1, 1, 1); PG8_STAGE(PG8_SB(1, 0), b3, voffB);
            PG8_BAR; PG8_WAIT_L(0); PG8_MMA(0, 1, At, B1); PG8_BAR;
            PG8_LDA(At, 1, 1); PG8_STAGE(PG8_SA(1, 0), a3, voffA);
            PG8_BAR; PG8_WAIT_L(0); PG8_MMA(1, 0, At, B0); PG8_BAR; PG8_SCHED;
            PG8_STAGE(PG8_SB(1, 1), b3 + hstep, voffB);
            PG8_WAIT_V(6); PG8_BAR; PG8_MMA(1, 1, At, B1); PG8_BAR;
            }
        }
        if constexpr (ALIGN_EPI) { if (wr == 0) PG8_BAR; }
        if constexpr (!Epi::AFTER_DRAIN) { E(acc, cur, wr, wc, fr, fq); S.done(cur); }
        if (!has_next) break;
#pragma unroll
        for (int a = 0; a < 2; ++a)
#pragma unroll
            for (int b = 0; b < 2; ++b)
#pragma unroll
                for (int m = 0; m < 4; ++m)
#pragma unroll
                    for (int n = 0; n < 2; ++n) acc[a][b][m][n] = (f32x4){0.f, 0.f, 0.f, 0.f};
        cur = nxt; cA = nA; cB = nB; ++ui;
        if constexpr (ALIGN_EPI) { if (wr == 1) PG8_BAR; }
    }
    PG8_WAIT_V(0);
    if constexpr (!ALIGN_EPI) { if (wr == 0) PG8_BAR; }
    PG8_BAR;
    if constexpr (Epi::AFTER_DRAIN) { E.fused(acc, cur, wr, wc, fr, fq, lds, wid, lane); S.done(cur); }
#undef PG8_SA
#undef PG8_SB
#undef PG8_STAGE
#undef PG8_LDA
#undef PG8_LDB
#undef PG8_MMA
#undef PG8_WAIT_V
#undef PG8_WAIT_L
#undef PG8_BAR
#undef PG8_SCHED
}
}
namespace attn_body {
using bf16=__hip_bfloat16;
using bf16x8=__attribute__((ext_vector_type(8)))short;
using s16x4=__attribute__((ext_vector_type(4)))short;
using f32x16=__attribute__((ext_vector_type(16)))float;
using u32x4=__attribute__((ext_vector_type(4)))unsigned;
constexpr int D=64,QP=2304,KP=2304,OP=1024,NTILES=260;
constexpr int NW=8,QBLK=32,QB=QBLK*NW,KVBLK=64;
__device__ __forceinline__ int crow(int r,int hi){return (r&3)+8*(r>>2)+4*hi;}
#define SBAR() __builtin_amdgcn_sched_barrier(0)
__device__ __forceinline__ void cmask(f32x16&p0,f32x16&p1,int jb,int qrel,int hi){
  const float NEG=-INFINITY; int kb=64*jb+4*hi;
  #pragma unroll
  for(int r=0;r<16;++r){int kv=kb+(r&3)+8*(r>>2); if(kv>qrel)p0[r]=NEG; if(kv+32>qrel)p1[r]=NEG;}
}

constexpr int NSLOT=3, SLOTB=8192;
constexpr int LDS_K=0, LDS_V=NSLOT*SLOTB, LDS_WS=2*NSLOT*SLOTB, LDS_OST=LDS_WS+NW*64*4, LDS_BYTES=LDS_OST+NW*4096;
constexpr float C2=0.125f*1.4426950408889634f;
__device__ __forceinline__ void glds16(const void*gsrc,unsigned lds_dst){unsigned keep;
  asm volatile("s_mov_b32 %0, m0\n\ts_mov_b32 m0, %2\n\ts_nop 0\n\tglobal_load_lds_dwordx4 %1, off\n\ts_mov_b32 m0, %0":"=&s"(keep):"v"(gsrc),"s"(lds_dst):"memory");}
__device__ __forceinline__ float max3f(float a,float b,float c){float r;asm("v_max3_f32 %0, %1, %2, %3":"=v"(r):"v"(a),"v"(b),"v"(c));return r;}
__device__ __forceinline__ float max2f(float a,float b){float r;asm("v_max_f32_e32 %0, %1, %2":"=v"(r):"v"(a),"v"(b));return r;}
__device__ __forceinline__ float fadd_s(float a,float b){float r;asm("v_add_f32_e32 %0, %1, %2":"=v"(r):"v"(a),"v"(b));return r;}
__device__ __forceinline__ float fsub_s(float a,float b){float r;asm("v_sub_f32_e32 %0, %1, %2":"=v"(r):"v"(a),"v"(b));return r;}
typedef float f32x2_t __attribute__((ext_vector_type(2))); typedef __bf16 bf16x2_t __attribute__((ext_vector_type(2)));
__device__ __forceinline__ unsigned cvtpk_s(float lo,float hi){f32x2_t v={lo,hi};bf16x2_t b=__builtin_convertvector(v,bf16x2_t);return __builtin_bit_cast(unsigned,b);}
#define WAIT_BAR(N) asm volatile("s_waitcnt vmcnt(" #N ") lgkmcnt(0)\n\ts_barrier":::"memory")

__device__ __forceinline__ void qkt(f32x16&p0,f32x16&p1,const char*Kslot,const bf16x8*qr,const f32x16&negm,int r32,int hi){
  const char*kb=Kslot+hi*1024+r32*16;
  #pragma unroll
  for(int d0=0;d0<4;++d0){
    const bf16x8 b0=*reinterpret_cast<const bf16x8*>(kb+d0*2048);
    const bf16x8 b1=*reinterpret_cast<const bf16x8*>(kb+d0*2048+512);
    if(d0==0){p0=__builtin_amdgcn_mfma_f32_32x32x16_bf16(b0,qr[0],negm,0,0,0);p1=__builtin_amdgcn_mfma_f32_32x32x16_bf16(b1,qr[0],negm,0,0,0);}
    else{p0=__builtin_amdgcn_mfma_f32_32x32x16_bf16(b0,qr[d0],p0,0,0,0);p1=__builtin_amdgcn_mfma_f32_32x32x16_bf16(b1,qr[d0],p1,0,0,0);}}
}
typedef __attribute__((address_space(3))) const char* lds_cptr;
typedef short v4i16_t __attribute__((ext_vector_type(4)));
__device__ __forceinline__ void kload8(bf16x8*kf,lds_cptr kp){
  kf[0]=*(const __attribute__((address_space(3))) bf16x8*)(kp);      kf[1]=*(const __attribute__((address_space(3))) bf16x8*)(kp+512);
  kf[2]=*(const __attribute__((address_space(3))) bf16x8*)(kp+2048); kf[3]=*(const __attribute__((address_space(3))) bf16x8*)(kp+2560);
  kf[4]=*(const __attribute__((address_space(3))) bf16x8*)(kp+4096); kf[5]=*(const __attribute__((address_space(3))) bf16x8*)(kp+4608);
  kf[6]=*(const __attribute__((address_space(3))) bf16x8*)(kp+6144); kf[7]=*(const __attribute__((address_space(3))) bf16x8*)(kp+6656);
}
__device__ __forceinline__ void kload2(bf16x8*kf,lds_cptr kp,int j){ kf[2*j]=*(const __attribute__((address_space(3))) bf16x8*)(kp+j*2048); kf[2*j+1]=*(const __attribute__((address_space(3))) bf16x8*)(kp+j*2048+512); }
__device__ __forceinline__ s16x4 vtr(lds_cptr p){ return __builtin_bit_cast(s16x4,__builtin_amdgcn_ds_read_tr16_b64_v4i16((__attribute__((address_space(3))) v4i16_t*)p)); }
__device__ __forceinline__ float rowmax(const f32x16&p0,const f32x16&p1){
  float a=max3f(p0[0],p0[1],p1[0]),b=max3f(p0[2],p0[3],p1[1]);a=max3f(a,p1[2],p1[3]);
  #pragma unroll
  for(int r=4;r<16;r+=4){a=max3f(a,p0[r],p0[r+1]);b=max3f(b,p0[r+2],p0[r+3]);a=max3f(a,p1[r],p1[r+1]);b=max3f(b,p1[r+2],p1[r+3]);}
  const float m=max2f(a,b);
  auto rr=__builtin_amdgcn_permlane32_swap(__float_as_uint(m),__float_as_uint(m),false,false);
  return max2f(__uint_as_float(rr[0]),__uint_as_float(rr[1]));
}
__device__ __forceinline__ void pv(f32x16*o,int vb,bf16x8 pa0,bf16x8 pa1,bf16x8 pa2,bf16x8 pa3){
  #pragma unroll
  for(int d0=0;d0<2;++d0){s16x4 lo[4],hi[4];
    #pragma unroll
    for(int ks=0;ks<4;++ks){
      asm volatile("ds_read_b64_tr_b16 %0,%1 offset:%c2":"=&v"(lo[ks]):"v"(vb),"i"(d0*4096+ks*1024):"memory");
      asm volatile("ds_read_b64_tr_b16 %0,%1 offset:%c2":"=&v"(hi[ks]):"v"(vb),"i"(d0*4096+ks*1024+512):"memory");}
    asm volatile("s_waitcnt lgkmcnt(0)":::"memory");SBAR();
    #define PK(k) (bf16x8){lo[k][0],lo[k][1],lo[k][2],lo[k][3],hi[k][0],hi[k][1],hi[k][2],hi[k][3]}
    o[d0]=__builtin_amdgcn_mfma_f32_32x32x16_bf16(pa0,PK(0),o[d0],0,0,0);
    o[d0]=__builtin_amdgcn_mfma_f32_32x32x16_bf16(pa1,PK(1),o[d0],0,0,0);
    o[d0]=__builtin_amdgcn_mfma_f32_32x32x16_bf16(pa2,PK(2),o[d0],0,0,0);
    o[d0]=__builtin_amdgcn_mfma_f32_32x32x16_bf16(pa3,PK(3),o[d0],0,0,0);
    #undef PK
  }
}

#ifndef ATTN_STORE16
#define ATTN_STORE16(p,v) (*(u32x4*)(p)=(v))
#endif
template<int THRL> __device__ __forceinline__ void attn_unit(int qb,const bf16*Q,const bf16*__restrict__ K,const bf16*__restrict__ V,bf16*O,char*shm){
  int tid=threadIdx.x; asm volatile("":"+v"(tid)); const int lane=tid&63,r32=lane&31,hi=lane>>5; const int wid=__builtin_amdgcn_readfirstlane(tid>>6);
  const int q0=qb*QB;
  const bf16*Qw=Q+(long)(q0+wid*QBLK)*QP;
  const bf16*Kh=K,*Vh=V;
  const unsigned lds0=(unsigned)(uintptr_t)shm;
  float*wsf=(float*)(shm+LDS_WS)+wid*64;
  const bf16*ksrc=Kh+(long)lane*KP+wid*8;
  const bf16*vsrc=Vh+(long)(16*(wid&3)+(lane>>2))*KP+(wid>>2)*32+(lane&3)*8;
  const unsigned kdst=lds0+LDS_K+wid*1024, vdst=lds0+LDS_V+wid*1024;
  #define DMA_K(t,slot) glds16(ksrc+(long)(t)*KVBLK*KP,(unsigned)__builtin_amdgcn_readfirstlane(kdst+(slot)))
  #define DMA_V(t,slot) glds16(vsrc+(long)(t)*KVBLK*KP,(unsigned)__builtin_amdgcn_readfirstlane(vdst+(slot)))
  const int vb0=(int)(lds0+LDS_V)+((lane>>4)&1)*32+(lane&3)*8+(4*hi+((lane&15)>>2))*64;
  const char*Kbase=shm+LDS_K; bf16x8 kf[8];
  const lds_cptr shm3=(lds_cptr)shm; const lds_cptr kp0=shm3+LDS_K+hi*1024+r32*16; const lds_cptr vp0=shm3+LDS_V+((lane>>4)&1)*32+(lane&3)*8+(4*hi+((lane&15)>>2))*64;
  const int NT=NTILES;
  DMA_K(0,0);DMA_V(0,0);DMA_K(1,SLOTB);
  bf16x8 qr[4];
  #pragma unroll
  for(int d0=0;d0<4;++d0)qr[d0]=*reinterpret_cast<const bf16x8*>(&Qw[(long)r32*QP+d0*16+hi*8]);
  float mhat=0.f,l_reg=0.f;f32x16 o[2];o[0]=f32x16{};o[1]=f32x16{};f32x16 negm=f32x16{};asm volatile("":"+v"(negm));
  const int qrel=wid*QBLK+r32;
  #define CMASK(P0,P1,t) do{}while(0)
  bool resc=false;
  #define START(P0,P1) do{ const float rm=rowmax(P0,P1); resc=false; \
    { const float dl=rm; mhat=fadd_s(mhat,dl); \
      _Pragma("unroll") for(int r=0;r<16;++r){P0[r]=fsub_s(P0[r],dl);P1[r]=fsub_s(P1[r],dl);} \
      _Pragma("unroll") for(int r=0;r<16;++r)negm[r]=-mhat; asm volatile("":"+v"(negm)); } \
    _Pragma("unroll") for(int r=0;r<16;++r)P0[r]=__builtin_amdgcn_exp2f(P0[r]); }while(0)
  #define RESC() do{ if(resc){ asm volatile("s_waitcnt lgkmcnt(0)":::"memory"); \
      _Pragma("unroll") for(int d_=0;d_<2;++d_) _Pragma("unroll") for(int r=0;r<16;++r)o[d_][r]*=wsf[crow(r,hi)]; } }while(0)
  f32x16 pA0,pA1,pB0,pB1;
  int sl_prev=0,sl_cur=0,sl_next=SLOTB;
  #define ROT() do{sl_prev=sl_cur;sl_cur=sl_next;sl_next=(sl_next==(NSLOT-1)*SLOTB)?0:sl_next+SLOTB;}while(0)
  DMA_K(2,2*SLOTB);
  WAIT_BAR(3);
  qkt(pA0,pA1,Kbase,qr,negm,r32,hi);asm volatile("s_nop 15\n\ts_nop 7":"+v"(pA0),"+v"(pA1));CMASK(pA0,pA1,0);
  START(pA0,pA1);
  _Pragma("unroll") for(int r=0;r<16;++r)pA1[r]=__builtin_amdgcn_exp2f(pA1[r]);
  WAIT_BAR(0);
  DMA_K(3,0);DMA_V(1,SLOTB);
  ROT();
  kload8(kf,kp0+sl_cur);
  WAIT_BAR(2);
  s16x4 vlo[8],vhi[8]; u32x4 pw0,pw1,pw2,pw3;
  #define PKW(P,B) cvtpk_s(P[B],P[B+1])
  #define PAF(k) __builtin_bit_cast(bf16x8,pw##k)
  #define VFR(i) (bf16x8){vlo[i][0],vlo[i][1],vlo[i][2],vlo[i][3],vhi[i][0],vhi[i][1],vhi[i][2],vhi[i][3]}
  #define PIN(x) asm volatile("":"+v"(x))
  #define MX3(a,b,c) __builtin_fmaxf(__builtin_fmaxf((a),(b)),(c))
  #define GAPA(MF,A0,A1,A2,A3,W0,W1,PW) do{ MF; sacc+=A0; sacc+=A1; sacc+=A2; sacc+=A3; PIN(sacc); W0; W1; PIN(PW); SBAR(); }while(0)
  #define EX(v) __builtin_amdgcn_exp2f(v)
  #define GAPB(MF,X,B) do{ MF; X[B]=EX(X[B]); X[B+1]=EX(X[B+1]); X[B+2]=EX(X[B+2]); X[B+3]=EX(X[B+3]); PIN(X); SBAR(); }while(0)
  #define VRD(i) do{ vlo[i]=vtr(vp_+(((i)>>2)*4096+((i)&3)*1024)); vhi[i]=vtr(vp_+(((i)>>2)*4096+((i)&3)*1024+512)); }while(0)
  #define KRD(G,j) do{ if(G){ kload2(kf,kp0+sl_next,j); SBAR(); } }while(0)
  #define STEP(C0,C1,P0,P1,t,GK,GV,GL) do{ SBAR(); \
    const lds_cptr vp_=vp0+sl_prev; \
    VRD(0); SBAR(); float sacc=(P0[0]+P0[1]); \
    GAPA(C0=__builtin_amdgcn_mfma_f32_32x32x16_bf16(kf[0],qr[0],negm,0,0,0), P0[2],P0[3],P0[4],P0[5],     pw0[0]=PKW(P0,0), pw0[1]=PKW(P0,2), pw0); \
    VRD(4); SBAR(); GAPA(C1=__builtin_amdgcn_mfma_f32_32x32x16_bf16(kf[1],qr[0],negm,0,0,0), P0[6],P0[7],P0[8],P0[9],     pw0[2]=PKW(P0,4), pw0[3]=PKW(P0,6), pw0); \
    VRD(1); SBAR(); GAPA(C0=__builtin_amdgcn_mfma_f32_32x32x16_bf16(kf[2],qr[1],C0,0,0,0),   P0[10],P0[11],P0[12],P0[13], pw1[0]=PKW(P0,8), pw1[1]=PKW(P0,10), pw1); \
    VRD(5); SBAR(); GAPA(C1=__builtin_amdgcn_mfma_f32_32x32x16_bf16(kf[3],qr[1],C1,0,0,0),   P0[14],P0[15],P1[0],P1[1],   pw1[2]=PKW(P0,12),pw1[3]=PKW(P0,14), pw1); \
    VRD(2); SBAR(); GAPA(C0=__builtin_amdgcn_mfma_f32_32x32x16_bf16(kf[4],qr[2],C0,0,0,0),   P1[2],P1[3],P1[4],P1[5],     pw2[0]=PKW(P1,0), pw2[1]=PKW(P1,2), pw2); \
    VRD(6); SBAR(); GAPA(C1=__builtin_amdgcn_mfma_f32_32x32x16_bf16(kf[5],qr[2],C1,0,0,0),   P1[6],P1[7],P1[8],P1[9],     pw2[2]=PKW(P1,4), pw2[3]=PKW(P1,6), pw2); \
    VRD(3); SBAR(); GAPA(C0=__builtin_amdgcn_mfma_f32_32x32x16_bf16(kf[6],qr[3],C0,0,0,0),   P1[10],P1[11],P1[12],P1[13], pw3[0]=PKW(P1,8), pw3[1]=PKW(P1,10), pw3); \
    VRD(7); SBAR(); GAPA(C1=__builtin_amdgcn_mfma_f32_32x32x16_bf16(kf[7],qr[3],C1,0,0,0),   P1[14],P1[15],0.f,0.f,       pw3[2]=PKW(P1,12),pw3[3]=PKW(P1,14), pw3); \
    l_reg+=sacc; \
    if(GK){DMA_K((t)+3,sl_cur);} if(GV){DMA_V((t)+1,sl_next);} \
    CMASK(C0,C1,t); \
    { float a=MX3(C0[0],C0[1],C1[0]),b=MX3(C0[2],C0[3],C1[1]); a=MX3(a,C1[2],C1[3]); \
      _Pragma("unroll") for(int r=4;r<16;r+=4){a=MX3(a,C0[r],C0[r+1]);b=MX3(b,C0[r+2],C0[r+3]);a=MX3(a,C1[r],C1[r+1]);b=MX3(b,C1[r+2],C1[r+3]);} \
      float rm=__builtin_fmaxf(a,b); { auto rr=__builtin_amdgcn_permlane32_swap(__float_as_uint(rm),__float_as_uint(rm),false,false); rm=__builtin_fmaxf(__uint_as_float(rr[0]),__uint_as_float(rr[1])); } \
      resc=false; \
      if(__builtin_expect(__any(rm>(float)THRL),0)){ const float dl=__builtin_fmaxf(rm,0.f); mhat+=dl; \
        _Pragma("unroll") for(int r=0;r<16;++r){C0[r]-=dl;C1[r]-=dl;} \
        _Pragma("unroll") for(int r=0;r<16;++r)negm[r]=-mhat; asm volatile("":"+v"(negm)); \
        const float f=__builtin_amdgcn_exp2f(-dl); l_reg*=f; if(hi==0)wsf[r32]=f; resc=true; } } \
    SBAR(); \
    GAPB(o[0]=__builtin_amdgcn_mfma_f32_32x32x16_bf16(PAF(0),VFR(0),o[0],0,0,0), C0,0); \
    GAPB(o[1]=__builtin_amdgcn_mfma_f32_32x32x16_bf16(PAF(0),VFR(4),o[1],0,0,0), C0,4); \
    KRD(GL,0); GAPB(o[0]=__builtin_amdgcn_mfma_f32_32x32x16_bf16(PAF(1),VFR(1),o[0],0,0,0), C0,8); \
    KRD(GL,1); GAPB(o[1]=__builtin_amdgcn_mfma_f32_32x32x16_bf16(PAF(1),VFR(5),o[1],0,0,0), C0,12); \
    KRD(GL,2); GAPB(o[0]=__builtin_amdgcn_mfma_f32_32x32x16_bf16(PAF(2),VFR(2),o[0],0,0,0), C1,0); \
    KRD(GL,3); GAPB(o[1]=__builtin_amdgcn_mfma_f32_32x32x16_bf16(PAF(2),VFR(6),o[1],0,0,0), C1,4); \
    GAPB(o[0]=__builtin_amdgcn_mfma_f32_32x32x16_bf16(PAF(3),VFR(3),o[0],0,0,0), C1,8); \
    GAPB(o[1]=__builtin_amdgcn_mfma_f32_32x32x16_bf16(PAF(3),VFR(7),o[1],0,0,0), C1,12); \
    }while(0)
  int t=1;
  #undef CMASK
  #define CMASK(P0,P1,t) do{}while(0)
  for(;t+5<NT;t+=2){
    STEP(pB0,pB1,pA0,pA1,t,true,true,true);     WAIT_BAR(2); RESC(); ROT();
    STEP(pA0,pA1,pB0,pB1,t+1,true,true,true);   WAIT_BAR(2); RESC(); ROT();
  }
  #undef CMASK
  #define CMASK(P0,P1,t) do{}while(0)
  #define ENDW(tt) do{ if((tt)+3<NT){WAIT_BAR(2);} else if((tt)+2<NT){WAIT_BAR(1);} else {WAIT_BAR(0);} }while(0)
  for(;t+1<NT;t+=2){
    STEP(pB0,pB1,pA0,pA1,t,(t+3<NT),(t+1<NT),(t+1<NT));       ENDW(t);   RESC(); ROT();
    STEP(pA0,pA1,pB0,pB1,t+1,(t+4<NT),(t+2<NT),(t+2<NT));     ENDW(t+1); RESC(); ROT();
  }
  STEP(pB0,pB1,pA0,pA1,NT-1,false,false,false); RESC();
  { float sacc=pB0[0]+pB0[1]; _Pragma("unroll") for(int r=2;r<16;++r)sacc+=pB0[r]; _Pragma("unroll") for(int r=0;r<16;++r)sacc+=pB1[r]; l_reg+=sacc;
    pw0=(u32x4){PKW(pB0,0),PKW(pB0,2),PKW(pB0,4),PKW(pB0,6)};pw1=(u32x4){PKW(pB0,8),PKW(pB0,10),PKW(pB0,12),PKW(pB0,14)};pw2=(u32x4){PKW(pB1,0),PKW(pB1,2),PKW(pB1,4),PKW(pB1,6)};pw3=(u32x4){PKW(pB1,8),PKW(pB1,10),PKW(pB1,12),PKW(pB1,14)};
    SBAR(); pv(o,vb0+sl_cur,PAF(0),PAF(1),PAF(2),PAF(3)); }
  #undef PKW
  #undef PAF
  #undef VFR
  #undef PIN
  #undef MX3
  #undef GAPA
  #undef GAPB
  #undef EX
  #undef VRD
  #undef KRD
  #undef STEP
  #undef ENDW
  {auto rr=__builtin_amdgcn_permlane32_swap(__float_as_uint(l_reg),__float_as_uint(l_reg),false,false);l_reg=__uint_as_float(rr[0])+__uint_as_float(rr[1]);}
  if(hi==0)wsf[32+r32]=l_reg;asm volatile("s_waitcnt lgkmcnt(0)":::"memory");
  float rli[16];
  #pragma unroll
  for(int r=0;r<16;++r)rli[r]=__builtin_amdgcn_rcpf(wsf[32+crow(r,hi)]);
  bf16*Ow=O+(long)(q0+wid*QBLK)*OP;
  { bf16*stg=(bf16*)(shm+LDS_OST)+wid*2048;
    #pragma unroll
    for(int r=0;r<16;++r){const int orow=crow(r,hi);
      #pragma unroll
      for(int d0=0;d0<2;++d0)stg[orow*64+d0*32+r32]=__float2bfloat16(o[d0][r]*rli[r]);}
    asm volatile("s_waitcnt lgkmcnt(0)":::"memory");
    #pragma unroll
    for(int i=0;i<4;++i){const int row=i*8+(lane>>3),ch=lane&7; const u32x4 v=*(const u32x4*)(stg+row*64+ch*8); ATTN_STORE16(Ow+(long)row*OP+ch*8,v);} }
  asm volatile("s_waitcnt lgkmcnt(0)\n\ts_barrier":::"memory");
  #undef DMA_K
  #undef DMA_V
  #undef CMASK
  #undef START
  #undef RESC
  #undef ROT
}
constexpr int ATTN_LDS_BYTES=LDS_BYTES;
struct AttnTensors { const bf16* Q; const bf16* K; const bf16* V; bf16* O; };
struct AttnUnit { int bh; int qb; };
}
#define LAS __attribute__((address_space(3)))
typedef unsigned short bf16_t;
typedef short bf16x8 __attribute__((ext_vector_type(8)));
typedef short s16x4 __attribute__((ext_vector_type(4)));
typedef float f32x4 __attribute__((ext_vector_type(4)));
typedef float f32x16 __attribute__((ext_vector_type(16)));
typedef unsigned u32x4 __attribute__((ext_vector_type(4)));
typedef unsigned u32x2 __attribute__((ext_vector_type(2)));

#define XB_TMO      128
#define XB_XCNT(j)  (256  + 64 * (j))
#define XB_XSUB(j)  (1280 + 64 * (j))
#define XB_XGEN(j)  (2304 + 64 * (j))
#define XB_TOP      3328
#define XB_TOPGEN   3392
#define XCD_BAR_WORDS 3456
#define XB_SPIN_CAP (1u << 18)

__device__ __forceinline__ unsigned xb_ld(unsigned* p)              { return __hip_atomic_load(p, __ATOMIC_RELAXED, __HIP_MEMORY_SCOPE_AGENT); }
__device__ __forceinline__ unsigned xb_add(unsigned* p, unsigned v) { return __hip_atomic_fetch_add(p, v, __ATOMIC_RELAXED, __HIP_MEMORY_SCOPE_AGENT); }
__device__ __forceinline__ unsigned xb_xcc_id() { return (unsigned)__builtin_amdgcn_s_getreg((3 << 11) | 20) & 0xFu; }
#define XB_SPIN(cond, bar) do { unsigned _sp = 0; while (cond) { __builtin_amdgcn_s_sleep(1); \
    if ((++_sp & 255u) == 0u) { if (xb_ld(&(bar)[XB_TMO])) break; if (_sp > XB_SPIN_CAP) { atomicAdd(&(bar)[XB_TMO], 1u); break; } } } } while (0)

struct XcdBarrier {
    unsigned* bar; unsigned x;
    volatile LAS unsigned* st;
};

__device__ __forceinline__ XcdBarrier xcd_barrier_post(unsigned* bar, volatile LAS unsigned* st, int tid) {
    XcdBarrier b; b.bar = bar; b.x = xb_xcc_id(); b.st = st;
    if (tid == 0) (void)xb_add(&bar[XB_XCNT(b.x)], 1u);
    return b;
}
__device__ __forceinline__ void xcd_barrier_complete(unsigned* bar, unsigned x, unsigned& nloc, unsigned& nx) {
    const unsigned G = gridDim.x * gridDim.y * gridDim.z;
    unsigned sum, cnt, mine, sp = 0u;
    for (;;) {
        sum = 0u; cnt = 0u; mine = 0u;
#pragma unroll
        for (unsigned j = 0; j < 16; ++j) { const unsigned c = xb_ld(&bar[XB_XCNT(j)]); sum += c; cnt += (c > 0u) ? 1u : 0u; mine = (j == x) ? c : mine; }
        if (sum == G) break;
        __builtin_amdgcn_s_sleep(1);
        if ((++sp & 255u) == 0u) { if (xb_ld(&bar[XB_TMO])) break; if (sp > XB_SPIN_CAP) { atomicAdd(&bar[XB_TMO], 1u); break; } }
    }
    nloc = mine > 0u ? mine : 1u; nx = cnt > 0u ? cnt : 1u;
}

__device__ __forceinline__ void xcd_barrier(const XcdBarrier& b, int tid) {
    asm volatile("s_waitcnt vmcnt(0)" ::: "memory");
    __syncthreads();
    if (tid == 0) {
        unsigned* bar = b.bar;
        __builtin_amdgcn_s_waitcnt(0);
        unsigned nloc = b.st[0], nx = b.st[1];
        if (nloc == 0u) { xcd_barrier_complete(bar, b.x, nloc, nx); b.st[0] = nloc; b.st[1] = nx; }
        const unsigned old = xb_add(&bar[XB_XSUB(b.x)], 1u);
        const unsigned gen = old / nloc;
        if (old + 1u == (gen + 1u) * nloc) {
            __builtin_amdgcn_fence(__ATOMIC_RELEASE, "agent");
            asm volatile("s_waitcnt vmcnt(0)" ::: "memory");
            const unsigned og = xb_add(&bar[XB_TOP], 1u);
            const unsigned tg = og / nx;
            if (og + 1u == (tg + 1u) * nx) xb_add(&bar[XB_TOPGEN], 1u);
            else XB_SPIN(xb_ld(&bar[XB_TOPGEN]) == tg, bar);
            __builtin_amdgcn_fence(__ATOMIC_ACQUIRE, "agent");
            xb_add(&bar[XB_XGEN(b.x)], 1u);
            asm volatile("s_waitcnt vmcnt(0)" ::: "memory");
        } else {
            XB_SPIN(xb_ld(&bar[XB_XGEN(b.x)]) == gen, bar);
            __builtin_amdgcn_fence(__ATOMIC_ACQUIRE, "agent");
            asm volatile("s_waitcnt vmcnt(0)" ::: "memory");
        }
    }
    __syncthreads();
}

constexpr int S_LAT = 16384, N_CTX = 256, MT = 16640, DM = 1024, N_EVEN = 2304, N_ODD = 1280, FF = 2816, NU = 5632, NMOD = 6144;
constexpr float DN_ALPHA = 1.6817928305074290f, LOG2E = 1.4426950408889634f, QC2 = 0.125f * 1.4426950408889634f, LN_EPS = 1e-5f;
constexpr size_t MiB = 1u << 20;
constexpr size_t WS_MODS = 0, WS_BAR = 224 * 1024  , WS_ROPE = 256 * 1024, WS_WIN = 1 * MiB, WS_WOUT = 6 * MiB, WS_WUP = 8 * MiB, WS_WDN = 19 * MiB, WS_XS = 25 * MiB, WS_R1 = 90 * MiB, WS_O = WS_R1 + 74 * MiB,
                 WS_HF = 269 * MiB, WS_XN = WS_HF + 1 * MiB, WS_PART = 359 * MiB, WS_END = 371 * MiB;
static_assert((size_t)MT * N_EVEN * 2 <= 74 * MiB && WS_R1 + (size_t)MT * NU * 2 <= WS_HF && WS_HF + (size_t)MT * FF * 2 <= WS_PART && (size_t)(MT + 512) * DM * 2 + MiB <= (size_t)MT * FF * 2, "ws map");
constexpr int LDS_BYTES = 147456 + 64, LDS_BARST = 147456;

struct Args { const float* in[20]; float* out; unsigned char* ws; };
typedef const __attribute__((address_space(4))) Args* ArgsP;
__device__ __forceinline__ ArgsP relaunder(ArgsP p) { asm volatile("" : "+s"(p)); return p; }

__device__ __forceinline__ unsigned pk2(float lo, float hi) { return pg8::pk_bf16(lo, hi); }
__device__ __forceinline__ float bf_lo(unsigned w) { return __uint_as_float(w << 16); }
__device__ __forceinline__ float bf_hi(unsigned w) { return __uint_as_float(w & 0xffff0000u); }
__device__ __forceinline__ float wave_sum(float v) {
#pragma unroll
    for (int o = 1; o < 64; o <<= 1) v += __shfl_xor(v, o);
    return v;
}
__device__ __forceinline__ float silu_f(float v) { return v / (1.0f + __expf(-v)); }

template <int KIND> __device__ __forceinline__ int cmap(int cp) {
    if (KIND == 0) return cp;
    if (KIND == 3) { const int pn = cp >> 8, bj = (cp >> 7) & 1, x = cp & 127; return FF * bj + 128 * pn + x; }
    const int pn = cp >> 8, bj = (cp >> 7) & 1, wc = (cp >> 5) & 3, p = cp & 31, hb = 256 * pn + 64 * wc;
    const bool rope = hb < (KIND == 1 ? 640 : 1152);
    const int d32 = rope ? (16 * ((p >> 2) & 1) + 4 * (p >> 3) + (p & 3)) : p;
    return hb + 32 * bj + d32;
}
template <int KIND> __device__ __forceinline__ void transpose_item(const float* W, int K, int N, bf16_t* WT, LAS float* scr, int item, int lane) {
    const int nblk = N / 32, kb = item / nblk, nb = item % nblk, k0 = 64 * kb, n0 = 32 * nb;
    const int o0 = cmap<KIND>(n0) & ~31;
#pragma unroll 8
    for (int i = 0; i < 32; ++i) { const int kk = 2 * i + (lane >> 5); scr[kk * 33 + (lane & 31)] = W[(size_t)(k0 + kk) * N + o0 + (lane & 31)]; }
    asm volatile("s_waitcnt lgkmcnt(0)" ::: "memory");
    const int c = lane & 7;
#pragma unroll
    for (int j = 0; j < 4; ++j) { const int n = (lane >> 3) + 8 * j; const int sidx = cmap<KIND>(n0 + n) - o0; const LAS float* s = scr + (8 * c) * 33 + sidx;
        u32x4 o; o.x = pk2(s[0 * 33], s[1 * 33]); o.y = pk2(s[2 * 33], s[3 * 33]); o.z = pk2(s[4 * 33], s[5 * 33]); o.w = pk2(s[6 * 33], s[7 * 33]);
        *(u32x4*)(WT + (size_t)(n0 + n) * K + k0 + 8 * c) = o; }
    asm volatile("s_waitcnt lgkmcnt(0)" ::: "memory");
}
__device__ __forceinline__ void convert_layer(ArgsP a, int l, LAS unsigned char* lds, int gw, int ngw, int wave, int lane) {
    LAS float* scr = (LAS float*)(lds + wave * 16384);
    unsigned char* ws = a->ws;
    const int i = l >> 1; const bool odd = l & 1;
    const int n_in = odd ? N_ODD : N_EVEN;
    const float* w_in = odd ? a->in[13] + (size_t)i * DM * N_ODD : a->in[8] + (size_t)i * DM * N_EVEN;
    const float* w_out = (odd ? a->in[14] : a->in[9]) + (size_t)i * DM * DM;
    const float* w_up = a->in[16] + (size_t)l * DM * NU;
    const float* w_dn = a->in[19] + (size_t)l * FF * DM;
    const int I_IN = (DM / 64) * (n_in / 32), I_OUT = (DM / 64) * (DM / 32), I_UP = (DM / 64) * (NU / 32), I_DN = (FF / 64) * (DM / 32);
    const int total = I_IN + I_OUT + I_UP + I_DN;
    for (int it = gw; it < total; it += ngw) {
        int r = it;
        if (r < I_IN) { if (odd) transpose_item<2>(w_in, DM, n_in, (bf16_t*)(ws + WS_WIN), scr, r, lane); else transpose_item<1>(w_in, DM, n_in, (bf16_t*)(ws + WS_WIN), scr, r, lane); continue; } r -= I_IN;
        if (r < I_OUT) { transpose_item<0>(w_out, DM, DM, (bf16_t*)(ws + WS_WOUT), scr, r, lane); continue; } r -= I_OUT;
        if (r < I_UP) { transpose_item<3>(w_up, DM, NU, (bf16_t*)(ws + WS_WUP), scr, r, lane); continue; } r -= I_UP;
        transpose_item<0>(w_dn, FF, DM, (bf16_t*)(ws + WS_WDN), scr, r, lane);
    }
}

__device__ __forceinline__ void phase_adaln(ArgsP a, LAS unsigned char* lds, int bid, int G, int tid, int wave, int lane) {
    LAS float* red = (LAS float*)(lds + 8 * 16384);
    const float* c = a->in[1]; const float* cc = a->in[3]; const float* ada_w = a->in[4]; const float* ada_b = a->in[5];
    float* mods = (float*)(a->ws + WS_MODS);
    for (int task = bid; task < 96; task += G) {
        const int l = task / 24, cgp = task % 24;
        const float* W = ada_w + (size_t)l * DM * NMOD + cgp * 256 + 4 * lane;
        f32x4 a0 = {0.f, 0.f, 0.f, 0.f}, a1 = {0.f, 0.f, 0.f, 0.f};
#pragma unroll 8
        for (int kk = 0; kk < 128; ++kk) { const int k = wave * 128 + kk; const float s0 = silu_f(c[k]), s1 = silu_f(cc[k]);
            const f32x4 w = *(const f32x4*)(W + (size_t)k * NMOD); a0 += w * s0; a1 += w * s1; }
#pragma unroll
        for (int j = 0; j < 4; ++j) { red[(wave * 2 + 0) * 256 + 4 * lane + j] = a0[j]; red[(wave * 2 + 1) * 256 + 4 * lane + j] = a1[j]; }
        __syncthreads();
        { const int v = tid >> 8, col = tid & 255; float s = 0.f;
#pragma unroll
          for (int w = 0; w < 8; ++w) s += red[(w * 2 + v) * 256 + col];
          mods[(size_t)(l * 2 + v) * NMOD + cgp * 256 + col] = s + ada_b[l * NMOD + cgp * 256 + col]; }
        __syncthreads();
    }
}
__device__ __forceinline__ void rope_tables(ArgsP a, int tid) {
    float* cosT = (float*)(a->ws + WS_ROPE); float* sinT = cosT + 4096;
    for (int idx = tid; idx < 4096; idx += 512) { const int pos = idx >> 4, i = idx & 15;
        const float f = exp2f(-(float)i * (13.287712379549449f / 16.0f)); const float ang = (float)pos * f;
        cosT[idx] = __cosf(ang); sinT[idx] = __sinf(ang); }
}
__device__ __forceinline__ void phase_init(ArgsP a, int gw, int ngw, int lane) {
    float* XS = (float*)(a->ws + WS_XS); bf16_t* XN = (bf16_t*)(a->ws + WS_XN); const float* mods = (const float*)(a->ws + WS_MODS);
    for (int r = gw; r < MT; r += ngw) {
        const bool isc = r >= S_LAT; const float* src = isc ? a->in[2] + (size_t)(r - S_LAT) * DM : a->in[0] + (size_t)r * DM;
        const float* mv = mods + (isc ? NMOD : 0);
#pragma unroll
        for (int j = 0; j < 4; ++j) { const int c0 = 4 * lane + 256 * j; const f32x4 x = *(const f32x4*)(src + c0), sh = *(const f32x4*)(mv + c0), sc = *(const f32x4*)(mv + DM + c0);
            *(f32x4*)(XS + (size_t)r * DM + c0) = x * DN_ALPHA; const f32x4 h = x * (sc + 1.0f) + sh;
            u32x2 w; w.x = pk2(h[0], h[1]); w.y = pk2(h[2], h[3]); *(u32x2*)(XN + (size_t)r * DM + c0) = w; }
    }
}
__device__ __forceinline__ void phase_ln(ArgsP a, int nrows, int npart, const float* gate_ctx, const float* g, const float* b, const float* mod_lat  , float* dout, int gw, int ngw, int lane) {
    float* XS = (float*)(a->ws + WS_XS); bf16_t* XN = (bf16_t*)(a->ws + WS_XN);
    for (int r = gw; r < nrows; r += ngw) {
        const float* zr = XS + (size_t)r * DM;
        f32x4 v[4]; float s = 0.f;
#pragma unroll
        for (int j = 0; j < 4; ++j) v[j] = *(const f32x4*)(zr + 4 * lane + 256 * j);
        if (r >= S_LAT) { const float* pr = (const float*)(a->ws + WS_PART) + (size_t)(r - S_LAT) * DM + 4 * lane;
            f32x4 ps[4];
#pragma unroll
            for (int j = 0; j < 4; ++j) ps[j] = (f32x4){0.f, 0.f, 0.f, 0.f};
            for (int kc = 0; kc < npart; ++kc) {
#pragma unroll
                for (int j = 0; j < 4; ++j) ps[j] += *(const f32x4*)(pr + (size_t)kc * 256 * DM + 256 * j); }
#pragma unroll
            for (int j = 0; j < 4; ++j) v[j] += ps[j] * *(const f32x4*)(gate_ctx + 4 * lane + 256 * j); }
#pragma unroll
        for (int j = 0; j < 4; ++j) s += (v[j][0] + v[j][1]) + (v[j][2] + v[j][3]);
        const float mean = wave_sum(s) * (1.0f / DM); float s2 = 0.f;
#pragma unroll
        for (int j = 0; j < 4; ++j) { v[j] = v[j] - mean; s2 += (v[j][0] * v[j][0] + v[j][1] * v[j][1]) + (v[j][2] * v[j][2] + v[j][3] * v[j][3]); }
        const float rstd = 1.0f / sqrtf(wave_sum(s2) * (1.0f / DM) + LN_EPS);
        const float* mv = mod_lat ? mod_lat + (r >= S_LAT ? NMOD : 0) : nullptr;
#pragma unroll
        for (int j = 0; j < 4; ++j) { const int c0 = 4 * lane + 256 * j; const f32x4 x = v[j] * rstd * *(const f32x4*)(g + c0) + *(const f32x4*)(b + c0);
            if (dout) *(f32x4*)(dout + (size_t)r * DM + c0) = x;
            else { *(f32x4*)(XS + (size_t)r * DM + c0) = x * DN_ALPHA;
                const f32x4 h = x * (*(const f32x4*)(mv + DM + c0) + 1.0f) + *(const f32x4*)(mv + c0);
                u32x2 w; w.x = pk2(h[0], h[1]); w.y = pk2(h[2], h[3]); *(u32x2*)(XN + (size_t)r * DM + c0) = w; } }
    }
}
__device__ __forceinline__ void unpack8(const u32x4 w, float (&f)[8]) { f[0] = bf_lo(w.x); f[1] = bf_hi(w.x); f[2] = bf_lo(w.y); f[3] = bf_hi(w.y); f[4] = bf_lo(w.z); f[5] = bf_hi(w.z); f[6] = bf_lo(w.w); f[7] = bf_hi(w.w); }
__device__ __forceinline__ void phase_conv(ArgsP a, int l, int nrows, int gtid, int ngt) {
    const bf16_t* U = (const bf16_t*)(a->ws + WS_R1); bf16_t* HF = (bf16_t*)(a->ws + WS_HF);
    const float* cw = a->in[17] + (size_t)l * 3 * NU; const float* cb = a->in[18] + (size_t)l * NU;
    const int nitems = (nrows / 8) * 352;
    for (int idx = gtid; idx < nitems; idx += ngt) {
        const int chunk = idx % 352, rb = idx / 352, row0 = rb * 8, c = chunk * 8;
        const int seg_lo = row0 < S_LAT ? 0 : S_LAT, seg_hi = row0 < S_LAT ? S_LAT : MT;
        const int ucol = 256 * (c >> 7) + (c & 127);
        float wa[3][8], wg[3][8], ba[8], bg[8];
#pragma unroll
        for (int j = 0; j < 3; ++j) {
#pragma unroll
            for (int e = 0; e < 8; e += 4) { const f32x4 x = *(const f32x4*)(cw + j * NU + c + e), y = *(const f32x4*)(cw + j * NU + FF + c + e);
                wa[j][e] = x[0]; wa[j][e + 1] = x[1]; wa[j][e + 2] = x[2]; wa[j][e + 3] = x[3]; wg[j][e] = y[0]; wg[j][e + 1] = y[1]; wg[j][e + 2] = y[2]; wg[j][e + 3] = y[3]; } }
#pragma unroll
        for (int e = 0; e < 8; e += 4) { const f32x4 x = *(const f32x4*)(cb + c + e), y = *(const f32x4*)(cb + FF + c + e);
            ba[e] = x[0]; ba[e + 1] = x[1]; ba[e + 2] = x[2]; ba[e + 3] = x[3]; bg[e] = y[0]; bg[e + 1] = y[1]; bg[e + 2] = y[2]; bg[e + 3] = y[3]; }
        const u32x4 zero = {0u, 0u, 0u, 0u};
        const bf16_t* up = U + (size_t)row0 * NU + ucol;
        u32x4 pa = zero, pg = zero, ca, cg_, na, ng;
        if (row0 - 1 >= seg_lo) { pa = *(const u32x4*)(up - NU); pg = *(const u32x4*)(up - NU + 128); }
        ca = *(const u32x4*)(up); cg_ = *(const u32x4*)(up + 128);
#pragma unroll
        for (int i = 0; i < 8; ++i) {
            const int row = row0 + i;
            if (row + 1 < seg_hi) { na = *(const u32x4*)(up + (size_t)(i + 1) * NU); ng = *(const u32x4*)(up + (size_t)(i + 1) * NU + 128); } else { na = zero; ng = zero; }
            float fpa[8], fca[8], fna[8], fpg[8], fcg[8], fng[8], h[8];
            unpack8(pa, fpa); unpack8(ca, fca); unpack8(na, fna); unpack8(pg, fpg); unpack8(cg_, fcg); unpack8(ng, fng);
#pragma unroll
            for (int e = 0; e < 8; ++e) { const float av = ba[e] + wa[0][e] * fpa[e] + wa[1][e] * fca[e] + wa[2][e] * fna[e]; const float gv = bg[e] + wg[0][e] * fpg[e] + wg[1][e] * fcg[e] + wg[2][e] * fng[e];
                h[e] = silu_f(gv) * av; }
            u32x4 o; o.x = pk2(h[0], h[1]); o.y = pk2(h[2], h[3]); o.z = pk2(h[4], h[5]); o.w = pk2(h[6], h[7]);
            *(u32x4*)(HF + (size_t)row * FF + c) = o;
            pa = ca; pg = cg_; ca = na; cg_ = ng;
        }
    }
}

typedef short v4i16_t __attribute__((ext_vector_type(4)));
template <int MODE>
__device__ __forceinline__ void wave_attn(const bf16_t* Q, const bf16_t* K, const bf16_t* V, bf16_t* O, int pitch, int qtok, int nloc, int kbase, int kstride,
                                          const LAS float* rpb, bool has_sink, float sink_l2, LAS unsigned char* vl, int lane) {
    const int r32 = lane & 31, hi = lane >> 5;
    bf16x8 qr[4];
    { const bf16_t* qp = Q + (size_t)qtok * pitch + 8 * hi;
#pragma unroll
      for (int d0 = 0; d0 < 4; ++d0) qr[d0] = *(const bf16x8*)(qp + 16 * d0); }
    float m = -1e30f, l = 0.f;
    f32x16 o0, o1;
#pragma unroll
    for (int r = 0; r < 16; ++r) { o0[r] = 0.f; o1[r] = 0.f; }
    const int ntile = nloc + 8;
    const int qrow = qtok >> 6, qcol = qtok & 63;
    const int rs_q = min(max(qrow - 4, 0), 248), cs_q = min(max(qcol - 8, 0), 48);
    bf16x8 kfn[4], vn[4];
    { const int kt = nloc > 0 ? kbase : S_LAT;
      const bf16_t* kp = K + (size_t)(kt + r32) * pitch + 8 * hi; const bf16_t* vp = V + (size_t)(kt + (lane >> 1)) * pitch + (lane & 1) * 32;
#pragma unroll
      for (int d0 = 0; d0 < 4; ++d0) { kfn[d0] = *(const bf16x8*)(kp + 16 * d0); vn[d0] = *(const bf16x8*)(vp + 8 * d0); } }
    const LAS unsigned char* vb = vl + (4 * hi + ((lane & 15) >> 2)) * 144 + ((lane >> 4) & 1) * 32 + (lane & 3) * 8;
    LAS unsigned char* vdst = vl + (lane >> 1) * 144 + (lane & 1) * 64;
    for (int u = 0; u < ntile; ++u) {
        bf16x8 kf[4], vr[4];
#pragma unroll
        for (int d0 = 0; d0 < 4; ++d0) { kf[d0] = kfn[d0]; vr[d0] = vn[d0]; }
        if (u + 1 < ntile) {
            const int kt = (u + 1 < nloc) ? kbase + kstride * (u + 1) : S_LAT + 32 * (u + 1 - nloc);
            const bf16_t* kp = K + (size_t)(kt + r32) * pitch + 8 * hi; const bf16_t* vp = V + (size_t)(kt + (lane >> 1)) * pitch + (lane & 1) * 32;
#pragma unroll
            for (int d0 = 0; d0 < 4; ++d0) { kfn[d0] = *(const bf16x8*)(kp + 16 * d0); vn[d0] = *(const bf16x8*)(vp + 8 * d0); }
        }
        asm volatile("" ::: "memory");
#pragma unroll
        for (int d0 = 0; d0 < 4; ++d0) *(LAS bf16x8*)(vdst + 16 * d0) = vr[d0];
        f32x16 s;
#pragma unroll
        for (int r = 0; r < 16; ++r) s[r] = 0.f;
#pragma unroll
        for (int d0 = 0; d0 < 4; ++d0) s = __builtin_amdgcn_mfma_f32_32x32x16_bf16(kf[d0], qr[d0], s, 0, 0, 0);
        if (MODE != 2 && u < nloc) {
            if (MODE == 0) {
                const int kr = (kbase >> 6) + u, c0 = kbase & 63;
                const bool rowok = (kr >= rs_q) && (kr < rs_q + 8);
                const int ib = (kr - qrow + 7) * 31 + (c0 - qcol + 15);
#pragma unroll
                for (int r = 0; r < 16; ++r) { const int kvl = (r & 3) + 8 * (r >> 2) + 4 * hi; const int kc = c0 + kvl;
                    const bool ok = rowok && (kc >= cs_q) && (kc < cs_q + 16);
                    const float bias = rpb[ok ? ib + kvl : 0];
                    s[r] = ok ? s[r] + bias : -1e30f; }
            } else {
                const int d0k = kbase + kstride * u - qtok;
#pragma unroll
                for (int r = 0; r < 16; ++r) { const int dd = d0k + (r & 3) + 8 * (r >> 2) + 4 * hi; s[r] = (dd >= -128 && dd <= 128) ? s[r] : -1e30f; }
            }
        }
        float tm = s[0];
#pragma unroll
        for (int r = 1; r < 16; ++r) tm = fmaxf(tm, s[r]);
        tm = fmaxf(tm, __shfl_xor(tm, 32));
        const float mn = fmaxf(m, tm), al = __builtin_amdgcn_exp2f(m - mn); m = mn;
        float rsum = 0.f;
#pragma unroll
        for (int r = 0; r < 16; ++r) { s[r] = __builtin_amdgcn_exp2f(s[r] - mn); rsum += s[r]; }
        l = l * al + rsum;
#pragma unroll
        for (int r = 0; r < 16; ++r) { o0[r] *= al; o1[r] *= al; }
        u32x4 w0, w1;
        w0.x = pk2(s[0], s[1]); w0.y = pk2(s[2], s[3]); w0.z = pk2(s[4], s[5]); w0.w = pk2(s[6], s[7]);
        w1.x = pk2(s[8], s[9]); w1.y = pk2(s[10], s[11]); w1.z = pk2(s[12], s[13]); w1.w = pk2(s[14], s[15]);
        const bf16x8 pf0 = __builtin_bit_cast(bf16x8, w0), pf1 = __builtin_bit_cast(bf16x8, w1);
        asm volatile("s_waitcnt lgkmcnt(0)" ::: "memory");
#pragma unroll
        for (int s2 = 0; s2 < 2; ++s2) {
#pragma unroll
            for (int d0 = 0; d0 < 2; ++d0) {
                const s16x4 lo = __builtin_bit_cast(s16x4, __builtin_amdgcn_ds_read_tr16_b64_v4i16((LAS v4i16_t*)(vb + (16 * s2) * 144 + d0 * 64)));
                const s16x4 hh = __builtin_bit_cast(s16x4, __builtin_amdgcn_ds_read_tr16_b64_v4i16((LAS v4i16_t*)(vb + (16 * s2 + 8) * 144 + d0 * 64)));
                const bf16x8 vf = {lo[0], lo[1], lo[2], lo[3], hh[0], hh[1], hh[2], hh[3]};
                if (d0 == 0) o0 = __builtin_amdgcn_mfma_f32_32x32x16_bf16(vf, s2 ? pf1 : pf0, o0, 0, 0, 0);
                else         o1 = __builtin_amdgcn_mfma_f32_32x32x16_bf16(vf, s2 ? pf1 : pf0, o1, 0, 0, 0);
            }
        }
        asm volatile("s_waitcnt lgkmcnt(0)" ::: "memory");
    }
    if (has_sink) { const float mn = fmaxf(m, sink_l2), al = __builtin_amdgcn_exp2f(m - mn); l = l * al + (hi == 0 ? __builtin_amdgcn_exp2f(sink_l2 - mn) : 0.f);
#pragma unroll
        for (int r = 0; r < 16; ++r) { o0[r] *= al; o1[r] *= al; } }
    l += __shfl_xor(l, 32);
    const float inv = 1.0f / l;
    bf16_t* op = O + (size_t)qtok * DM + 4 * hi;
#pragma unroll
    for (int g = 0; g < 4; ++g) {
        u32x2 wa, wb; wa.x = pk2(o0[4 * g] * inv, o0[4 * g + 1] * inv); wa.y = pk2(o0[4 * g + 2] * inv, o0[4 * g + 3] * inv);
        wb.x = pk2(o1[4 * g] * inv, o1[4 * g + 1] * inv); wb.y = pk2(o1[4 * g + 2] * inv, o1[4 * g + 3] * inv);
        *(u32x2*)(op + 8 * g) = wa; *(u32x2*)(op + 32 + 8 * g) = wb;
    }
}
__device__ __forceinline__ void phase_attn_waves(ArgsP a, int l, bool ctx_out, LAS unsigned char* lds, int gw, int ngw, int wave, int lane) {
    const bool odd = l & 1; const int li = l >> 1;
    const bf16_t* QKV = (const bf16_t*)(a->ws + WS_R1); bf16_t* OB = (bf16_t*)(a->ws + WS_O);
    const LAS float* rpbL = (const LAS float*)lds;
    LAS unsigned char* vl = lds + 16384 + wave * 4608;
    const int r32 = lane & 31;
    const int nmain = odd ? 8192 : 4096, total = nmain + (ctx_out ? 128 : 0);
    for (int idx = gw; idx < total; idx += ngw) {
        if (idx < nmain) {
            const int h = idx >> 9, qt = idx & 511;
            if (!odd) {
                const int rp = qt >> 2, cb = qt & 3;
                const int R0 = min(max(2 * rp - 4, 0), 247), C0 = min(max(16 * cb - 8, 0), 32);
                const int qtok = (2 * rp + (r32 >> 4)) * 64 + 16 * cb + (r32 & 15);
                wave_attn<0>(QKV + 768 + h * 64, QKV + 1280 + h * 64, QKV + 1792 + h * 64, OB + 512 + h * 64, N_EVEN, qtok, 9, R0 * 64 + C0, 64, rpbL + h * 465, false, 0.f, vl, lane);
            } else {
                const int ulo = max(0, 4 - qt), uhi = min(8, 515 - qt);
                const float sk = a->in[15][li * 16 + h] * LOG2E;
                wave_attn<1>(QKV + h * 64, QKV + 1024 + (h >> 3) * 64, QKV + 1152 + (h >> 3) * 64, OB + h * 64, N_ODD, 32 * qt + r32, uhi - ulo + 1, 32 * qt - 128 + 32 * ulo, 32, rpbL, true, sk, vl, lane);
            }
        } else {
            const int j = idx - nmain, h = (j >> 3) & (odd ? 15 : 7), qt = j & 7; const int qtok = S_LAT + 32 * qt + r32;
            const bf16_t *q, *k, *v; bf16_t* o; bool sink = false; float sk = 0.f;
            if (odd) { q = QKV + h * 64; k = QKV + 1024 + (h >> 3) * 64; v = QKV + 1152 + (h >> 3) * 64; o = OB + h * 64; sink = true; sk = a->in[15][li * 16 + h] * LOG2E; }
            else if (j < 64) { q = QKV + h * 64; k = QKV + 512 + (h >> 2) * 64; v = QKV + 640 + (h >> 2) * 64; o = OB + h * 64; }
            else { q = QKV + 768 + h * 64; k = QKV + 1280 + h * 64; v = QKV + 1792 + h * 64; o = OB + 512 + h * 64; }
            wave_attn<2>(q, k, v, o, odd ? N_ODD : N_EVEN, qtok, 0, 0, 0, rpbL, sink, sk, vl, lane);
        }
    }
}

#define FRESH_IDS() int tid = threadIdx.x; asm volatile("" : "+v"(tid)); const int lane = tid & 63, wave = __builtin_amdgcn_readfirstlane(tid >> 6); const int gw = bid * 8 + wave, ngw = G * 8; (void)lane; (void)gw; (void)ngw
#define GRID_BAR() do { int tid_b = threadIdx.x; asm volatile("" : "+v"(tid_b)); XcdBarrier xb_; xb_.bar = (unsigned*)(relaunder(ap)->ws + WS_BAR); xb_.x = xb_xcc_id(); xb_.st = (volatile LAS unsigned*)((LAS unsigned char*)lds_raw + LDS_BARST); xcd_barrier(xb_, tid_b); } while (0)
template <int L> __device__ __forceinline__ void run_layer(ArgsP ap, unsigned char* lds_raw, float* dout_unused) {
    constexpr int l = L; constexpr bool odd = (L & 1) != 0, ctx_out = L < 3; constexpr int li = L >> 1;
    constexpr int n_in = odd ? N_ODD : N_EVEN, m_rows = ctx_out ? MT : S_LAT;
    LAS unsigned char* lds = (LAS unsigned char*)lds_raw;
    const int G = gridDim.x, bid = blockIdx.x;
    {
        ArgsP a = relaunder(ap); unsigned char* ws = a->ws; const float* cosT = (const float*)(ws + WS_ROPE);
        pg8::Gemm g{(const bf16_t*)(ws + WS_XN), (const bf16_t*)(ws + WS_WIN), MT, n_in, DM, DM}; pg8::StaticOrder S; S.init(MT, n_in, G, bid);
        pg8::EpiInproj E{(bf16_t*)(ws + WS_R1), n_in, a->in[10] + li * 64, a->in[11] + li * 64, cosT, cosT + 4096, odd ? 0 : 512, odd ? 0 : 640, odd ? 1152 : 640, odd ? 1024 : 512, odd ? 0 : 768, odd ? 0 : 1280, QC2};
        pg8::gemm_phase<pg8::EpiInproj, pg8::StaticOrder, true, true>(lds, g, S, E);
    }
    GRID_BAR();
    if (!odd) {
        FRESH_IDS(); ArgsP a = relaunder(ap); unsigned char* ws = a->ws; const bf16_t* QKV = (const bf16_t*)(ws + WS_R1); bf16_t* OB = (bf16_t*)(ws + WS_O);
        const int vcu = (G % 8 == 0) ? (bid % 8) * (G / 8) + bid / 8 : bid;
        for (int unit = vcu; unit < 512; unit += G) { const int h = unit >> 6, qb = unit & 63;
            attn_body::attn_unit<8>(qb, (const attn_body::bf16*)(QKV + h * 64), (const attn_body::bf16*)(QKV + 512 + (h >> 2) * 64), (const attn_body::bf16*)(QKV + 640 + (h >> 2) * 64),
                                    (attn_body::bf16*)(OB + h * 64), (char*)lds_raw); }
        __syncthreads();
        { const float* rpb = a->in[12] + (size_t)li * 8 * 465; LAS float* rl = (LAS float*)lds;
          for (int i = tid; i < 8 * 465; i += 512) rl[i] = rpb[i] * LOG2E; }
        __syncthreads();
    }
    { FRESH_IDS(); phase_attn_waves(relaunder(ap), l, ctx_out, lds, gw, ngw, wave, lane); }
    GRID_BAR();
    {
        ArgsP a = relaunder(ap); unsigned char* ws = a->ws; const float* ml = (const float*)(ws + WS_MODS) + (size_t)(l * 2) * NMOD;
        { pg8::Gemm g{(const bf16_t*)(ws + WS_O), (const bf16_t*)(ws + WS_WOUT), S_LAT, DM, DM, DM}; pg8::StaticOrder S; S.init(S_LAT, DM, G, bid);
          pg8::EpiResid<false> E{(float*)(ws + WS_XS), ml + 2 * DM, ml + NMOD + 2 * DM, nullptr};
          pg8::gemm_phase<pg8::EpiResid<false>, pg8::StaticOrder, true, true>(lds, g, S, E); }
        if (ctx_out) {
          pg8::Gemm g{(const bf16_t*)(ws + WS_O) + (size_t)S_LAT * DM, (const bf16_t*)(ws + WS_WOUT), N_CTX, DM, 256, DM}; typedef pg8::SplitKOrder<4, 4, 256, 64> SKO; SKO S; S.init(G, bid);
          pg8::EpiResid<true> E{(float*)(ws + WS_XS), ml + 2 * DM, ml + NMOD + 2 * DM, (float*)(ws + WS_PART)};
          pg8::gemm_phase<pg8::EpiResid<true>, SKO, true, true>(lds, g, S, E); }
    }
    GRID_BAR();
    { FRESH_IDS(); ArgsP a = relaunder(ap); const float* ml = (const float*)(a->ws + WS_MODS) + (size_t)(l * 2) * NMOD;
      phase_ln(a, m_rows, 4, ml + NMOD + 2 * DM, a->in[6] + (size_t)(l * 2) * DM, a->in[7] + (size_t)(l * 2) * DM, ml + 3 * DM, nullptr, gw, ngw, lane); }
    GRID_BAR();
    {
        ArgsP a = relaunder(ap); unsigned char* ws = a->ws;
        pg8::Gemm g{(const bf16_t*)(ws + WS_XN), (const bf16_t*)(ws + WS_WUP), m_rows, NU, DM, DM}; pg8::StaticOrder S; S.init(m_rows, NU, G, bid);
        pg8::EpiStore E{(bf16_t*)(ws + WS_R1), NU};
        pg8::gemm_phase<pg8::EpiStore, pg8::StaticOrder, true, true>(lds, g, S, E);
    }
    GRID_BAR();
    { FRESH_IDS(); phase_conv(relaunder(ap), l, m_rows, bid * 512 + tid, G * 512); }
    GRID_BAR();
    {
        ArgsP a = relaunder(ap); unsigned char* ws = a->ws; const float* ml = (const float*)(ws + WS_MODS) + (size_t)(l * 2) * NMOD;
        { pg8::Gemm g{(const bf16_t*)(ws + WS_HF), (const bf16_t*)(ws + WS_WDN), S_LAT, DM, FF, FF}; pg8::StaticOrder S; S.init(S_LAT, DM, G, bid);
          pg8::EpiResid<false> E{(float*)(ws + WS_XS), ml + 5 * DM, ml + NMOD + 5 * DM, nullptr};
          pg8::gemm_phase<pg8::EpiResid<false>, pg8::StaticOrder, true, true>(lds, g, S, E); }
        if (ctx_out) {
          pg8::Gemm g{(const bf16_t*)(ws + WS_HF) + (size_t)S_LAT * FF, (const bf16_t*)(ws + WS_WDN), N_CTX, DM, 256, FF}; typedef pg8::SplitKOrder<4, 11, 256, 64> SKO; SKO S; S.init(G, bid);
          pg8::EpiResid<true> E{(float*)(ws + WS_XS), ml + 5 * DM, ml + NMOD + 5 * DM, (float*)(ws + WS_PART)};
          pg8::gemm_phase<pg8::EpiResid<true>, SKO, true, true>(lds, g, S, E); }
    }
    GRID_BAR();
    { FRESH_IDS(); ArgsP a = relaunder(ap);
      if (l < 3) { phase_ln(a, m_rows, 11, (const float*)(a->ws + WS_MODS) + (size_t)(l * 2 + 1) * NMOD + 5 * DM, a->in[6] + (size_t)(l * 2 + 1) * DM, a->in[7] + (size_t)(l * 2 + 1) * DM, (const float*)(a->ws + WS_MODS) + (size_t)((l + 1) * 2) * NMOD, nullptr, gw, ngw, lane);
                   convert_layer(relaunder(ap), l + 1, lds, gw, ngw, wave, lane); GRID_BAR(); }
      else phase_ln(a, S_LAT, 0, nullptr, a->in[6] + (size_t)(l * 2 + 1) * DM, a->in[7] + (size_t)(l * 2 + 1) * DM, nullptr, a->out, gw, ngw, lane); }
}

__global__ void __launch_bounds__(512, 2) mk_fwd(Args a_by_value) {
    extern __shared__ __attribute__((aligned(16))) unsigned char lds_raw[];
    cg::grid_group grid = cg::this_grid();
    const ArgsP ap = (ArgsP)__builtin_amdgcn_kernarg_segment_ptr();
    {
        LAS unsigned char* lds = (LAS unsigned char*)lds_raw;
        const int tid = threadIdx.x, lane = tid & 63, wave = __builtin_amdgcn_readfirstlane(tid >> 6);
        const int G = gridDim.x, bid = blockIdx.x, gw = bid * 8 + wave, ngw = G * 8;
        if (tid < 16) ((LAS unsigned*)(lds + LDS_BARST))[tid] = 0u;
        __syncthreads();
        (void)xcd_barrier_post((unsigned*)(relaunder(ap)->ws + WS_BAR), (volatile LAS unsigned*)(lds + LDS_BARST), tid);
        phase_adaln(relaunder(ap), lds, bid, G, tid, wave, lane);
        if (bid == G - 1) rope_tables(relaunder(ap), tid);
        convert_layer(relaunder(ap), 0, lds, gw, ngw, wave, lane);
        grid.sync();
        phase_init(relaunder(ap), gw, ngw, lane);
        GRID_BAR();
    }
    run_layer<0>(ap, lds_raw, nullptr);
    run_layer<1>(ap, lds_raw, nullptr);
    run_layer<2>(ap, lds_raw, nullptr);
    run_layer<3>(ap, lds_raw, nullptr);
}

extern "C" void kernel_launch(void* const* d_in, const int* in_sizes, int n_in, void* d_out, int out_size, void* d_ws, size_t ws_size, hipStream_t stream) {
    static int grid = 0;
    if (grid == 0) {
        if (n_in != 20 || out_size != S_LAT * DM || ws_size < WS_END) { fprintf(stderr, "kernel_launch: unexpected problem (n_in %d, out %d, ws %zu < %zu)\n", n_in, out_size, ws_size, (size_t)WS_END); grid = -1; return; }
        int dev = 0, cus = 0, per_cu = 0;
        (void)hipGetDevice(&dev); (void)hipDeviceGetAttribute(&cus, hipDeviceAttributeMultiprocessorCount, dev);
        if (hipFuncSetAttribute((const void*)mk_fwd, hipFuncAttributeMaxDynamicSharedMemorySize, LDS_BYTES) != hipSuccess) { fprintf(stderr, "kernel_launch: hipFuncSetAttribute failed\n"); grid = -1; return; }
        if (hipOccupancyMaxActiveBlocksPerMultiprocessor(&per_cu, (const void*)mk_fwd, 512, LDS_BYTES) != hipSuccess || per_cu < 1) { fprintf(stderr, "kernel_launch: occupancy query says %d\n", per_cu); per_cu = 1; }
        (void)hipGetLastError();
        grid = cus * 1;
        if (grid <= 0) grid = 256;
    }
    if (grid < 0) return;
    Args a{};
    for (int i = 0; i < 20; ++i) a.in[i] = (const float*)d_in[i];
    a.out = (float*)d_out; a.ws = (unsigned char*)d_ws;
    if (hipMemsetAsync((char*)d_ws + WS_BAR, 0, 16384, stream) != hipSuccess) { fprintf(stderr, "kernel_launch: memset failed\n"); return; }
    void* args[] = {&a};
    hipError_t e = hipLaunchCooperativeKernel((const void*)mk_fwd, dim3(grid), dim3(512), args, LDS_BYTES, stream);
    if (e != hipSuccess) fprintf(stderr, "cooperative launch failed: %s (grid %d)\n", hipGetErrorString(e), grid);
}
```

```cpp
#include <hip/hip_runtime.h>
#include <hip/hip_cooperative_groups.h>
#include <hip/hip_bf16.h>
#include <cstdio>
#include <cstdint>
#include <cmath>
namespace cg = cooperative_groups;
namespace pg8 {
#define PG8_LAS __attribute__((address_space(3)))
typedef unsigned short bf16_t;
typedef short bf16x8 __attribute__((ext_vector_type(8)));
typedef float f32x4 __attribute__((ext_vector_type(4)));
typedef unsigned u32x4 __attribute__((ext_vector_type(4)));
constexpr int BM = 256, BK = 64, HALF = 128, HTB = HALF * BK * 2  , STAGE_BYTES = 8 * HTB, NXCD = 8, WGM = 8;

__host__ __device__ __forceinline__ int lds_byte(int r, int c) { const int st = (r >> 4) * 2 + (c >> 5), rr = r & 15, cc = c & 31, ob = rr * 64 + cc * 2; return st * 1024 + (ob ^ (((ob >> 9) & 1) << 5)); }
__host__ __device__ __forceinline__ void stage_rc(int b, int& R, int& C) { const int st = b / 1024, sb = b % 1024, swz = sb ^ (((sb >> 9) & 1) << 5); R = (st >> 1) * 16 + swz / 64; C = (st & 1) * 32 + (swz % 64) / 2; }
__host__ __device__ __forceinline__ int perm32(int rho) { const int n = rho >> 4, i = rho & 15; return 8 * (i >> 2) + 4 * n + (i & 3); }

struct Unit { int pm, pn, arow, ko; };
struct Gemm { const bf16_t* A; const bf16_t* Bt; int M, N, K, ldk; };

struct StaticOrder {
    int nM, nN, nwg, G, c;
    __host__ __device__ void init(int M, int N, int G_, int c_) { nM = M / BM; nN = N / BM; nwg = nM * nN; G = G_; c = c_; }
    __host__ __device__ bool next(int i, Unit& u) const {
        const long L = (long)i * G + c; if (L >= nwg) return false;
        int wgid = (int)L; { const int q = nwg / NXCD, r = nwg % NXCD, xcd = wgid % NXCD, off = wgid / NXCD; wgid = (xcd < r ? xcd * (q + 1) : r * (q + 1) + (xcd - r) * q) + off; }
        const int nig = WGM * nN, gid = wgid / nig, fm = gid * WGM, gsz = (nM - fm) < WGM ? (nM - fm) : WGM;
        u.pm = fm + ((wgid % nig) % gsz); u.pn = (wgid % nig) / gsz; u.arow = u.pm * BM; u.ko = 0; return true;
    }
    __device__ __forceinline__ void a_ready(const Unit&) const {}
    __device__ __forceinline__ void done(const Unit&) const {}
};

template <int NN, int NKC, int KCHUNK, int PM_LABEL> struct SplitKOrder {
    int G, c;
    __host__ __device__ void init(int G_, int c_) { G = G_; c = c_; }
    __host__ __device__ bool next(int i, Unit& u) const { const int L = i * G + c; if (L >= NN * NKC) return false; u.pm = PM_LABEL; u.pn = L % NN; u.arow = 0; u.ko = (L / NN) * KCHUNK; return true; }
    __device__ __forceinline__ void a_ready(const Unit&) const {}
    __device__ __forceinline__ void done(const Unit&) const {}
};
__device__ __forceinline__ unsigned cvt_pk_bf16(float lo, float hi) { unsigned r; asm volatile("v_cvt_pk_bf16_f32 %0, %1, %2" : "=v"(r) : "v"(lo), "v"(hi)); return r; }
typedef float f32x2 __attribute__((ext_vector_type(2)));
__device__ __forceinline__ unsigned pk_bf16(float lo, float hi) { typedef float f2 __attribute__((ext_vector_type(2))); typedef __bf16 b2 __attribute__((ext_vector_type(2))); f2 v = {lo, hi}; b2 b = __builtin_convertvector(v, b2); return __builtin_bit_cast(unsigned, b); }

struct EpiInproj {
    static constexpr bool PERM = true, AFTER_DRAIN = false;
    bf16_t* O; int ldc;
    const float* qg; const float* kg;
    const float* cosT; const float* sinT;
    int rmsq_end, rms_end, rope_end, sc1_end, sc2_beg, sc2_end;
    float c2;
    __device__ __forceinline__ void operator()(const f32x4 (&acc)[2][2][4][2], const Unit& u, int wr, int wc, int fr, int fq) const {
        const int hb = u.pn * BM + wc * 64;
        const bool do_rms = hb < rms_end, do_rope = hb < rope_end;
        const float sc = (hb < sc1_end || (hb >= sc2_beg && hb < sc2_end)) ? c2 : 1.f;
        f32x4 gv[2][2];
#pragma unroll
        for (int bj = 0; bj < 2; ++bj)
#pragma unroll
            for (int n = 0; n < 2; ++n) gv[bj][n] = do_rms ? *(const f32x4*)((hb < rmsq_end ? qg : kg) + 32 * bj + 16 * n + 4 * fq) : (f32x4){1.f, 1.f, 1.f, 1.f};
#pragma unroll
        for (int ai = 0; ai < 2; ++ai)
#pragma unroll
            for (int m = 0; m < 4; ++m) {
                const int row = u.pm * BM + ai * HALF + wr * 64 + m * 16 + fr;
                f32x4 v[2][2];
#pragma unroll
                for (int bj = 0; bj < 2; ++bj)
#pragma unroll
                    for (int n = 0; n < 2; ++n) v[bj][n] = acc[ai][bj][m][n];
                if (do_rms) {
                    float ss = 0.f;
#pragma unroll
                    for (int bj = 0; bj < 2; ++bj)
#pragma unroll
                        for (int n = 0; n < 2; ++n) { const f32x4 x = v[bj][n]; ss += (x[0] * x[0] + x[1] * x[1]) + (x[2] * x[2] + x[3] * x[3]); }
                    ss += __shfl_xor(ss, 16); ss += __shfl_xor(ss, 32);
                    const float rinv = 1.0f / sqrtf(ss * (1.0f / 64.0f) + 1e-6f);
#pragma unroll
                    for (int bj = 0; bj < 2; ++bj)
#pragma unroll
                        for (int n = 0; n < 2; ++n) v[bj][n] = v[bj][n] * rinv * gv[bj][n];
                }
                if (do_rope && row < 16384) {
#pragma unroll
                    for (int bj = 0; bj < 2; ++bj) {
                        const int pos = bj ? (row & 63) : (row >> 6);
                        const f32x4 cs = *(const f32x4*)(cosT + pos * 16 + 4 * fq), sn = *(const f32x4*)(sinT + pos * 16 + 4 * fq);
                        const f32x4 x1 = v[bj][0], x2 = v[bj][1];
                        v[bj][0] = x1 * cs - x2 * sn; v[bj][1] = x2 * cs + x1 * sn;
                    }
                }
                bf16_t* rowp = O + (size_t)row * ldc + hb + 8 * fq;
#pragma unroll
                for (int bj = 0; bj < 2; ++bj) {
                    const f32x4 a = v[bj][0] * sc, b = v[bj][1] * sc;
                    u32x4 w; w.x = pk_bf16(a[0], a[1]); w.y = pk_bf16(a[2], a[3]); w.z = pk_bf16(b[0], b[1]); w.w = pk_bf16(b[2], b[3]);
                    *(u32x4*)(rowp + 32 * bj) = w;
                }
                asm volatile("" ::: "memory");
            }
    }
};
template <bool ATOMIC> struct EpiResid {
    static constexpr bool PERM = true, AFTER_DRAIN = false;
    float* XS; const float* gate_lat; const float* gate_ctx; float* PART;
    __device__ __forceinline__ void operator()(const f32x4 (&acc)[2][2][4][2], const Unit& u, int wr, int wc, int fr, int fq) const {
        asm volatile("" : "+v"(fr));
        int pm = u.pm; asm volatile("" : "+s"(pm));
        const float* gate = (pm >= 64) ? gate_ctx : gate_lat;
        const int col0 = u.pn * BM + wc * 32 + 8 * fq;
        f32x4 gv[2][2];
#pragma unroll
        for (int bj = 0; bj < 2; ++bj)
#pragma unroll
            for (int n = 0; n < 2; ++n) gv[bj][n] = ATOMIC ? (f32x4){1.f, 1.f, 1.f, 1.f} : *(const f32x4*)(gate + col0 + bj * HALF + 4 * n);
#pragma unroll
        for (int ai = 0; ai < 2; ++ai)
#pragma unroll
            for (int m = 0; m < 4; ++m) {
                float* rowp = XS + (size_t)(pm * BM + ai * HALF + wr * 64 + m * 16 + fr) * 1024 + col0;
#pragma unroll
                for (int bj = 0; bj < 2; ++bj)
#pragma unroll
                    for (int n = 0; n < 2; ++n) {
                        const f32x4 d = gv[bj][n] * acc[ai][bj][m][n];
                        if (ATOMIC) { *(f32x4*)(PART + ((size_t)(u.ko >> 8) * 256 + (pm - 64) * BM + (ai * HALF + wr * 64 + m * 16 + fr)) * 1024 + col0 + bj * HALF + 4 * n) = d; }
                        else { f32x4* p = (f32x4*)(rowp + bj * HALF + 4 * n); const f32x4 x = *p; *p = x + d; }
                    }
                if (m & 1) asm volatile("" ::: "memory");
            }
    }
};
struct EpiStore {
    static constexpr bool PERM = true, AFTER_DRAIN = false;
    bf16_t* O; int ldc;
    __device__ __forceinline__ void operator()(const f32x4 (&acc)[2][2][4][2], const Unit& u, int wr, int wc, int fr, int fq) const {
        const int col0 = u.pn * BM + wc * 32 + 8 * fq;
#pragma unroll
        for (int ai = 0; ai < 2; ++ai)
#pragma unroll
            for (int m = 0; m < 4; ++m) {
                bf16_t* rowp = O + (size_t)(u.pm * BM + ai * HALF + wr * 64 + m * 16 + fr) * ldc + col0;
#pragma unroll
                for (int bj = 0; bj < 2; ++bj) { const f32x4 a = acc[ai][bj][m][0], b = acc[ai][bj][m][1];
                    u32x4 w; w.x = pk_bf16(a[0], a[1]); w.y = pk_bf16(a[2], a[3]); w.z = pk_bf16(b[0], b[1]); w.w = pk_bf16(b[2], b[3]);
                    *(u32x4*)(rowp + bj * HALF) = w; }
            }
    }
};

template <int CTRL> __device__ __forceinline__ float dpp_mov(float old, float src) {
    return __int_as_float(__builtin_amdgcn_update_dpp(__float_as_int(old), __float_as_int(src), CTRL, 0xf, 0xf, false));
}
struct EpiUpConv {
    static constexpr bool PERM = true, AFTER_DRAIN = false;
    bf16_t* HF; const float* cw; const float* cb; PG8_LAS float* X;
    __device__ __forceinline__ void operator()(const f32x4 (&acc)[2][2][4][2], const Unit& u, int wr, int wc, int fr, int fq) const {
        asm volatile("" : "+v"(fr));
        const int arow = u.arow;
        const int seg_lo = (u.pm >= 65) ? 16384 : 0, seg_hi = (u.pm >= 65) ? 16640 : 16384;
        const int out_hi = (arow + 255 < seg_hi) ? arow + 255 : seg_hi;
        const int lc = wc * 32 + 8 * fq;
#pragma unroll
        for (int ai = 0; ai < 2; ++ai)
#pragma unroll
            for (int bj = 0; bj < 2; ++bj)
#pragma unroll
                for (int n = 0; n < 2; ++n) {
                    if (fr == 0)  *(PG8_LAS f32x4*)(X + (((2 * ai + wr) * 2 + 0) * 2 + bj) * 128 + lc + 4 * n) = acc[ai][bj][0][n];
                    if (fr == 15) *(PG8_LAS f32x4*)(X + (((2 * ai + wr) * 2 + 1) * 2 + bj) * 128 + lc + 4 * n) = acc[ai][bj][3][n];
                }
        asm volatile("s_waitcnt lgkmcnt(0)" ::: "memory"); __builtin_amdgcn_s_barrier(); asm volatile("" ::: "memory");
        const int c0 = u.pn * 128 + lc;
#pragma unroll
        for (int ai = 0; ai < 2; ++ai) {
            const int blk = 2 * ai + wr;
#pragma unroll
            for (int n = 0; n < 2; ++n) {
                f32x4 w0[2], w1[2], w2[2], bb[2], pv[2], nv[2];
#pragma unroll
                for (int bj = 0; bj < 2; ++bj) {
                    const int cc = bj * 2816 + c0 + 4 * n;
                    w0[bj] = *(const f32x4*)(cw + cc); w1[bj] = *(const f32x4*)(cw + 5632 + cc); w2[bj] = *(const f32x4*)(cw + 2 * 5632 + cc); bb[bj] = *(const f32x4*)(cb + cc);
                    pv[bj] = (f32x4){0.f, 0.f, 0.f, 0.f}; nv[bj] = (f32x4){0.f, 0.f, 0.f, 0.f};
                    if (blk > 0) pv[bj] = *(const PG8_LAS f32x4*)(X + (((blk - 1) * 2 + 1) * 2 + bj) * 128 + lc + 4 * n);
                    if (blk < 3) nv[bj] = *(const PG8_LAS f32x4*)(X + (((blk + 1) * 2 + 0) * 2 + bj) * 128 + lc + 4 * n);
                }
#pragma unroll
                for (int m = 0; m < 4; ++m) {
                    const int rr = ai * HALF + wr * 64 + m * 16 + fr, t = arow + rr;
                    f32x4 pre[2];
#pragma unroll
                    for (int bj = 0; bj < 2; ++bj) {
                        const f32x4 x = acc[ai][bj][m][n];
                        f32x4 xp, xn;
#pragma unroll
                        for (int j = 0; j < 4; ++j) {
                            const float oldp = (m > 0) ? dpp_mov<0x121>(0.f, acc[ai][bj][m > 0 ? m - 1 : 0][n][j]) : pv[bj][j];
                            xp[j] = dpp_mov<0x111>(oldp, x[j]);
                            const float oldn = (m < 3) ? dpp_mov<0x12F>(0.f, acc[ai][bj][m < 3 ? m + 1 : 3][n][j]) : nv[bj][j];
                            xn[j] = dpp_mov<0x101>(oldn, x[j]);
                        }
                        if (t - 1 < seg_lo) xp = (f32x4){0.f, 0.f, 0.f, 0.f};
                        if (t + 1 >= seg_hi) xn = (f32x4){0.f, 0.f, 0.f, 0.f};
                        pre[bj] = bb[bj] + w0[bj] * xp + w1[bj] * x + w2[bj] * xn;
                    }
                    float hv[4];
#pragma unroll
                    for (int j = 0; j < 4; ++j) { const float gv = pre[1][j]; hv[j] = gv / (1.0f + __expf(-gv)) * pre[0][j]; }
                    if (rr >= 1 && rr <= 254 && t < out_hi) {
                        typedef unsigned u32x2_t __attribute__((ext_vector_type(2)));
                        u32x2_t w; w.x = pk_bf16(hv[0], hv[1]); w.y = pk_bf16(hv[2], hv[3]);
                        *(u32x2_t*)(HF + (size_t)t * 2816 + c0 + 4 * n) = w;
                    }
                }
                asm volatile("" ::: "memory");
            }
        }
    }
};
struct ConvOrder {
    StaticOrder so;
    __host__ __device__ void init(int ntiles, int N, int G_, int c_) { so.init(ntiles * BM, N, G_, c_); }
    __host__ __device__ bool next(int i, Unit& u) const { if (!so.next(i, u)) return false; u.arow = (u.pm < 65) ? 254 * u.pm - 1 : 16384 + 254 * (u.pm - 65) - 1; return true; }
    __device__ __forceinline__ void a_ready(const Unit&) const {}
    __device__ __forceinline__ void done(const Unit&) const {}
};
template <class Epi, class Sched, bool ALIGN_EPI = false, bool SP2 = false>
__device__ __forceinline__ void gemm_phase(PG8_LAS unsigned char* lds, const Gemm g, const Sched& S, const Epi& E) {
    int tid = threadIdx.x; asm volatile("" : "+v"(tid));
    const int wid = __builtin_amdgcn_readfirstlane(tid >> 6), lane = tid & 63, wr = wid >> 2, wc = wid & 3, fr = lane & 15, fq = lane >> 4;
    const int K = g.ldk, nt = g.K / BK;
    unsigned voffA[2], voffB[2];
#pragma unroll
    for (int i = 0; i < 2; ++i) { int R, C; stage_rc(tid * 16 + i * 8192, R, C); const int Rb = Epi::PERM ? ((R & ~31) + perm32(R & 31)) : R;
        voffA[i] = (unsigned)(R * K + C) * 2u; voffB[i] = (unsigned)(Rb * K + C) * 2u; }
    const size_t kstep = (size_t)(BK * 2);
    const size_t hstep = (size_t)HALF * K * 2;
    const size_t tstep = 2 * hstep;
    const unsigned ldsw = (unsigned)wid * 1024u;
    const int aoff = lds_byte(wr * 64 + fr, fq * 8), boff = lds_byte(wc * 32 + fr, fq * 8);
#define PG8_SA(b, h) (((b) * 2 + (h)) * HTB)
#define PG8_SB(b, h) ((4 + (b) * 2 + (h)) * HTB)
#define PG8_STAGE(bufoff, gbase, voff) do { _Pragma("unroll") for (int _i = 0; _i < 2; ++_i) \
        __builtin_amdgcn_global_load_lds((const unsigned*)((const char*)(gbase) + (voff)[_i]), (PG8_LAS unsigned*)(lds + (bufoff) + ldsw + _i * 8192), 16, 0, 0); } while (0)
#define PG8_LDA(dst, b, h) do { _Pragma("unroll") for (int m = 0; m < 4; ++m) _Pragma("unroll") for (int k = 0; k < 2; ++k) dst[m][k] = *(const PG8_LAS bf16x8*)(lds + PG8_SA(b, h) + aoff + m * 2048 + k * 1024); } while (0)
#define PG8_LDB(dst, b, h) do { _Pragma("unroll") for (int n = 0; n < 2; ++n) _Pragma("unroll") for (int k = 0; k < 2; ++k) dst[n][k] = *(const PG8_LAS bf16x8*)(lds + PG8_SB(b, h) + boff + n * 2048 + k * 1024); } while (0)
#define PG8_MMA(ai, bj, At, Bt) do { __builtin_amdgcn_s_setprio(1); _Pragma("unroll") for (int m = 0; m < 4; ++m) _Pragma("unroll") for (int n = 0; n < 2; ++n) _Pragma("unroll") for (int k = 0; k < 2; ++k) \
        acc[ai][bj][m][n] = __builtin_amdgcn_mfma_f32_16x16x32_bf16(Bt[n][k], At[m][k], acc[ai][bj][m][n], 0, 0, 0); __builtin_amdgcn_s_setprio(0); } while (0)
#define PG8_WAIT_V(n) asm volatile("s_waitcnt vmcnt(" #n ")" ::: "memory")
#define PG8_WAIT_L(n) asm volatile("s_waitcnt lgkmcnt(" #n ")" ::: "memory")
#define PG8_BAR __builtin_amdgcn_s_barrier()
#define PG8_SCHED __builtin_amdgcn_sched_barrier(0)
    Unit cur, nxt; int ui = 0;
    if (!S.next(0, cur)) return;
    f32x4 acc[2][2][4][2];
#pragma unroll
    for (int a = 0; a < 2; ++a)
#pragma unroll
        for (int b = 0; b < 2; ++b)
#pragma unroll
            for (int m = 0; m < 4; ++m)
#pragma unroll
                for (int n = 0; n < 2; ++n) acc[a][b][m][n] = (f32x4){0.f, 0.f, 0.f, 0.f};
    bf16x8 At[4][2], B0[2][2], B1[2][2];
    const char* cA = (const char*)g.A + ((long)cur.arow * K + cur.ko) * 2; const char* cB = (const char*)g.Bt + (size_t)cur.pn * tstep + (size_t)cur.ko * 2;
    S.a_ready(cur);
    if constexpr (SP2) {
        PG8_STAGE(PG8_SB(0, 0), cB, voffB); PG8_STAGE(PG8_SB(0, 1), cB + hstep, voffB); PG8_STAGE(PG8_SA(0, 0), cA, voffA); PG8_STAGE(PG8_SA(0, 1), cA + hstep, voffA);
        if (wr == 1) PG8_BAR;
        PG8_WAIT_V(2); PG8_BAR;
        PG8_STAGE(PG8_SB(1, 0), cB + kstep, voffB); PG8_STAGE(PG8_SA(1, 0), cA + kstep, voffA); PG8_STAGE(PG8_SB(1, 1), cB + hstep + kstep, voffB);
        PG8_WAIT_V(6); PG8_BAR;
    } else {
        PG8_STAGE(PG8_SB(0, 0), cB, voffB); PG8_STAGE(PG8_SA(0, 0), cA, voffA); PG8_STAGE(PG8_SB(0, 1), cB + hstep, voffB); PG8_STAGE(PG8_SA(0, 1), cA + hstep, voffA);
        if (wr == 1) PG8_BAR;
        PG8_WAIT_V(4); PG8_BAR;
        PG8_STAGE(PG8_SB(1, 0), cB + kstep, voffB); PG8_STAGE(PG8_SA(1, 0), cA + kstep, voffA); PG8_STAGE(PG8_SB(1, 1), cB + hstep + kstep, voffB);
        PG8_WAIT_V(6); PG8_BAR;
    }
    for (;;) {
        const bool has_next = S.next(ui + 1, nxt);
        const char* nA = has_next ? (const char*)g.A + ((long)nxt.arow * K + nxt.ko) * 2 : cA; const char* nB = has_next ? (const char*)g.Bt + (size_t)nxt.pn * tstep + (size_t)nxt.ko * 2 : cB;
        for (int t = 0; t < nt; t += 2) {
            const bool last = (t == nt - 2);
            const char* a1 = cA + (size_t)(t + 1) * kstep;
            const char* a2 = last ? nA : cA + (size_t)(t + 2) * kstep; const char* b2 = last ? nB : cB + (size_t)(t + 2) * kstep;
            const char* a3 = a2 + kstep; const char* b3 = b2 + kstep;
            if (last && has_next) S.a_ready(nxt);
            if constexpr (SP2) {
            PG8_LDB(B0, 0, 0); PG8_LDB(B1, 0, 1); PG8_SCHED; PG8_LDA(At, 0, 0); PG8_STAGE(PG8_SA(1, 1), a1 + hstep, voffA);
            PG8_WAIT_V(8); PG8_WAIT_L(0); PG8_BAR; PG8_MMA(0, 0, At, B0); PG8_MMA(0, 1, At, B1); PG8_BAR; PG8_SCHED;
            PG8_LDA(At, 0, 1); PG8_STAGE(PG8_SB(0, 0), b2, voffB); PG8_STAGE(PG8_SB(0, 1), b2 + hstep, voffB); PG8_STAGE(PG8_SA(0, 0), a2, voffA);
            PG8_WAIT_V(8); PG8_WAIT_L(0); PG8_BAR; PG8_MMA(1, 0, At, B0); PG8_MMA(1, 1, At, B1); PG8_BAR; PG8_SCHED;
            PG8_LDB(B0, 1, 0); PG8_LDB(B1, 1, 1); PG8_SCHED; PG8_LDA(At, 1, 0); PG8_STAGE(PG8_SA(0, 1), a2 + hstep, voffA);
            PG8_WAIT_V(8); PG8_WAIT_L(0); PG8_BAR; PG8_MMA(0, 0, At, B0); PG8_MMA(0, 1, At, B1); PG8_BAR; PG8_SCHED;
            PG8_LDA(At, 1, 1); PG8_STAGE(PG8_SB(1, 0), b3, voffB); PG8_STAGE(PG8_SB(1, 1), b3 + hstep, voffB); PG8_STAGE(PG8_SA(1, 0), a3, voffA);
            PG8_WAIT_V(8); PG8_WAIT_L(0); PG8_BAR; PG8_MMA(1, 0, At, B0); PG8_MMA(1, 1, At, B1); PG8_BAR; PG8_SCHED;
            } else {
            PG8_LDB(B0, 0, 0); PG8_SCHED; PG8_LDA(At, 0, 0); PG8_STAGE(PG8_SA(1, 1), a1 + hstep, voffA);
            PG8_WAIT_L(8); PG8_BAR; PG8_WAIT_L(0); PG8_MMA(0, 0, At, B0); PG8_BAR; PG8_SCHED;
            PG8_LDB(B1, 0, 1); PG8_STAGE(PG8_SB(0, 0), b2, voffB);
            PG8_BAR; PG8_WAIT_L(0); PG8_MMA(0, 1, At, B1); PG8_BAR;
            PG8_LDA(At, 0, 1); PG8_STAGE(PG8_SA(0, 0), a2, voffA);
            PG8_BAR; PG8_WAIT_L(0); PG8_MMA(1, 0, At, B0); PG8_BAR; PG8_SCHED;
            PG8_STAGE(PG8_SB(0, 1), b2 + hstep, voffB);
            PG8_WAIT_V(6); PG8_BAR; PG8_MMA(1, 1, At, B1); PG8_BAR;
            PG8_LDB(B0, 1, 0); PG8_SCHED; PG8_LDA(At, 1, 0); PG8_STAGE(PG8_SA(0, 1), a2 + hstep, voffA);
            PG8_WAIT_L(8); PG8_BAR; PG8_WAIT_L(0); PG8_MMA(0, 0, At, B0); PG8_BAR; PG8_SCHED;
            PG8_LDB(B1, 1, 1); PG8_STAGE(PG8_SB(1, 0), b3, voffB);
            PG8_BAR; PG8_WAIT_L(0); PG8_MMA(0, 1, At, B1); PG8_BAR;
            PG8_LDA(At, 1, 1); PG8_STAGE(PG8_SA(1, 0), a3, voffA);
            PG8_BAR; PG8_WAIT_L(0); PG8_MMA(1, 0, At, B0); PG8_BAR; PG8_SCHED;
            PG8_STAGE(PG8_SB(1, 1), b3 + hstep, voffB);
            PG8_WAIT_V(6); PG8_BAR; PG8_MMA(1, 1, At, B1); PG8_BAR;
            }
        }
        if constexpr (ALIGN_EPI) { if (wr == 0) PG8_BAR; }
        if constexpr (!Epi::AFTER_DRAIN) { E(acc, cur, wr, wc, fr, fq); S.done(cur); }
        if (!has_next) break;
#pragma unroll
        for (int a = 0; a < 2; ++a)
#pragma unroll
            for (int b = 0; b < 2; ++b)
#pragma unroll
                for (int m = 0; m < 4; ++m)
#pragma unroll
                    for (int n = 0; n < 2; ++n) acc[a][b][m][n] = (f32x4){0.f, 0.f, 0.f, 0.f};
        cur = nxt; cA = nA; cB = nB; ++ui;
        if constexpr (ALIGN_EPI) { if (wr == 1) PG8_BAR; }
    }
    PG8_WAIT_V(0);
    if constexpr (!ALIGN_EPI) { if (wr == 0) PG8_BAR; }
    PG8_BAR;
    if constexpr (Epi::AFTER_DRAIN) { E.fused(acc, cur, wr, wc, fr, fq, lds, wid, lane); S.done(cur); }
#undef PG8_SA
#undef PG8_SB
#undef PG8_STAGE
#undef PG8_LDA
#undef PG8_LDB
#undef PG8_MMA
#undef PG8_WAIT_V
#undef PG8_WAIT_L
#undef PG8_BAR
#undef PG8_SCHED
}
}
namespace attn_body {
using bf16=__hip_bfloat16;
using bf16x8=__attribute__((ext_vector_type(8)))short;
using s16x4=__attribute__((ext_vector_type(4)))short;
using f32x16=__attribute__((ext_vector_type(16)))float;
using u32x4=__attribute__((ext_vector_type(4)))unsigned;
constexpr int D=64,QP=2304,KP=2304,OP=1024,NTILES=260;
constexpr int NW=8,QBLK=32,QB=QBLK*NW,KVBLK=64;
__device__ __forceinline__ int crow(int r,int hi){return (r&3)+8*(r>>2)+4*hi;}
#define SBAR() __builtin_amdgcn_sched_barrier(0)
__device__ __forceinline__ void cmask(f32x16&p0,f32x16&p1,int jb,int qrel,int hi){
  const float NEG=-INFINITY; int kb=64*jb+4*hi;
  #pragma unroll
  for(int r=0;r<16;++r){int kv=kb+(r&3)+8*(r>>2); if(kv>qrel)p0[r]=NEG; if(kv+32>qrel)p1[r]=NEG;}
}

constexpr int NSLOT=3, SLOTB=8192;
constexpr int LDS_K=0, LDS_V=NSLOT*SLOTB, LDS_WS=2*NSLOT*SLOTB, LDS_OST=LDS_WS+NW*64*4, LDS_BYTES=LDS_OST+NW*4096;
constexpr float C2=0.125f*1.4426950408889634f;
__device__ __forceinline__ void glds16(const void*gsrc,unsigned lds_dst){unsigned keep;
  asm volatile("s_mov_b32 %0, m0\n\ts_mov_b32 m0, %2\n\ts_nop 0\n\tglobal_load_lds_dwordx4 %1, off\n\ts_mov_b32 m0, %0":"=&s"(keep):"v"(gsrc),"s"(lds_dst):"memory");}
__device__ __forceinline__ float max3f(float a,float b,float c){float r;asm("v_max3_f32 %0, %1, %2, %3":"=v"(r):"v"(a),"v"(b),"v"(c));return r;}
__device__ __forceinline__ float max2f(float a,float b){float r;asm("v_max_f32_e32 %0, %1, %2":"=v"(r):"v"(a),"v"(b));return r;}
__device__ __forceinline__ float fadd_s(float a,float b){float r;asm("v_add_f32_e32 %0, %1, %2":"=v"(r):"v"(a),"v"(b));return r;}
__device__ __forceinline__ float fsub_s(float a,float b){float r;asm("v_sub_f32_e32 %0, %1, %2":"=v"(r):"v"(a),"v"(b));return r;}
typedef float f32x2_t __attribute__((ext_vector_type(2))); typedef __bf16 bf16x2_t __attribute__((ext_vector_type(2)));
__device__ __forceinline__ unsigned cvtpk_s(float lo,float hi){f32x2_t v={lo,hi};bf16x2_t b=__builtin_convertvector(v,bf16x2_t);return __builtin_bit_cast(unsigned,b);}
#define WAIT_BAR(N) asm volatile("s_waitcnt vmcnt(" #N ") lgkmcnt(0)\n\ts_barrier":::"memory")

__device__ __forceinline__ void qkt(f32x16&p0,f32x16&p1,const char*Kslot,const bf16x8*qr,const f32x16&negm,int r32,int hi){
  const char*kb=Kslot+hi*1024+r32*16;
  #pragma unroll
  for(int d0=0;d0<4;++d0){
    const bf16x8 b0=*reinterpret_cast<const bf16x8*>(kb+d0*2048);
    const bf16x8 b1=*reinterpret_cast<const bf16x8*>(kb+d0*2048+512);
    if(d0==0){p0=__builtin_amdgcn_mfma_f32_32x32x16_bf16(b0,qr[0],negm,0,0,0);p1=__builtin_amdgcn_mfma_f32_32x32x16_bf16(b1,qr[0],negm,0,0,0);}
    else{p0=__builtin_amdgcn_mfma_f32_32x32x16_bf16(b0,qr[d0],p0,0,0,0);p1=__builtin_amdgcn_mfma_f32_32x32x16_bf16(b1,qr[d0],p1,0,0,0);}}
}
typedef __attribute__((address_space(3))) const char* lds_cptr;
typedef short v4i16_t __attribute__((ext_vector_type(4)));
__device__ __forceinline__ void kload8(bf16x8*kf,lds_cptr kp){
  kf[0]=*(const __attribute__((address_space(3))) bf16x8*)(kp);      kf[1]=*(const __attribute__((address_space(3))) bf16x8*)(kp+512);
  kf[2]=*(const __attribute__((address_space(3))) bf16x8*)(kp+2048); kf[3]=*(const __attribute__((address_space(3))) bf16x8*)(kp+2560);
  kf[4]=*(const __attribute__((address_space(3))) bf16x8*)(kp+4096); kf[5]=*(const __attribute__((address_space(3))) bf16x8*)(kp+4608);
  kf[6]=*(const __attribute__((address_space(3))) bf16x8*)(kp+6144); kf[7]=*(const __attribute__((address_space(3))) bf16x8*)(kp+6656);
}
__device__ __forceinline__ void kload2(bf16x8*kf,lds_cptr kp,int j){ kf[2*j]=*(const __attribute__((address_space(3))) bf16x8*)(kp+j*2048); kf[2*j+1]=*(const __attribute__((address_space(3))) bf16x8*)(kp+j*2048+512); }
__device__ __forceinline__ s16x4 vtr(lds_cptr p){ return __builtin_bit_cast(s16x4,__builtin_amdgcn_ds_read_tr16_b64_v4i16((__attribute__((address_space(3))) v4i16_t*)p)); }
__device__ __forceinline__ float rowmax(const f32x16&p0,const f32x16&p1){
  float a=max3f(p0[0],p0[1],p1[0]),b=max3f(p0[2],p0[3],p1[1]);a=max3f(a,p1[2],p1[3]);
  #pragma unroll
  for(int r=4;r<16;r+=4){a=max3f(a,p0[r],p0[r+1]);b=max3f(b,p0[r+2],p0[r+3]);a=max3f(a,p1[r],p1[r+1]);b=max3f(b,p1[r+2],p1[r+3]);}
  const float m=max2f(a,b);
  auto rr=__builtin_amdgcn_permlane32_swap(__float_as_uint(m),__float_as_uint(m),false,false);
  return max2f(__uint_as_float(rr[0]),__uint_as_float(rr[1]));
}
__device__ __forceinline__ void pv(f32x16*o,int vb,bf16x8 pa0,bf16x8 pa1,bf16x8 pa2,bf16x8 pa3){
  #pragma unroll
  for(int d0=0;d0<2;++d0){s16x4 lo[4],hi[4];
    #pragma unroll
    for(int ks=0;ks<4;++ks){
      asm volatile("ds_read_b64_tr_b16 %0,%1 offset:%c2":"=&v"(lo[ks]):"v"(vb),"i"(d0*4096+ks*1024):"memory");
      asm volatile("ds_read_b64_tr_b16 %0,%1 offset:%c2":"=&v"(hi[ks]):"v"(vb),"i"(d0*4096+ks*1024+512):"memory");}
    asm volatile("s_waitcnt lgkmcnt(0)":::"memory");SBAR();
    #define PK(k) (bf16x8){lo[k][0],lo[k][1],lo[k][2],lo[k][3],hi[k][0],hi[k][1],hi[k][2],hi[k][3]}
    o[d0]=__builtin_amdgcn_mfma_f32_32x32x16_bf16(pa0,PK(0),o[d0],0,0,0);
    o[d0]=__builtin_amdgcn_mfma_f32_32x32x16_bf16(pa1,PK(1),o[d0],0,0,0);
    o[d0]=__builtin_amdgcn_mfma_f32_32x32x16_bf16(pa2,PK(2),o[d0],0,0,0);
    o[d0]=__builtin_amdgcn_mfma_f32_32x32x16_bf16(pa3,PK(3),o[d0],0,0,0);
    #undef PK
  }
}

#ifndef ATTN_STORE16
#define ATTN_STORE16(p,v) (*(u32x4*)(p)=(v))
#endif
template<int THRL> __device__ __forceinline__ void attn_unit(int qb,const bf16*Q,const bf16*__restrict__ K,const bf16*__restrict__ V,bf16*O,char*shm){
  int tid=threadIdx.x; asm volatile("":"+v"(tid)); const int lane=tid&63,r32=lane&31,hi=lane>>5; const int wid=__builtin_amdgcn_readfirstlane(tid>>6);
  const int q0=qb*QB;
  const bf16*Qw=Q+(long)(q0+wid*QBLK)*QP;
  const bf16*Kh=K,*Vh=V;
  const unsigned lds0=(unsigned)(uintptr_t)shm;
  float*wsf=(float*)(shm+LDS_WS)+wid*64;
  const bf16*ksrc=Kh+(long)lane*KP+wid*8;
  const bf16*vsrc=Vh+(long)(16*(wid&3)+(lane>>2))*KP+(wid>>2)*32+(lane&3)*8;
  const unsigned kdst=lds0+LDS_K+wid*1024, vdst=lds0+LDS_V+wid*1024;
  #define DMA_K(t,slot) glds16(ksrc+(long)(t)*KVBLK*KP,(unsigned)__builtin_amdgcn_readfirstlane(kdst+(slot)))
  #define DMA_V(t,slot) glds16(vsrc+(long)(t)*KVBLK*KP,(unsigned)__builtin_amdgcn_readfirstlane(vdst+(slot)))
  const int vb0=(int)(lds0+LDS_V)+((lane>>4)&1)*32+(lane&3)*8+(4*hi+((lane&15)>>2))*64;
  const char*Kbase=shm+LDS_K; bf16x8 kf[8];
  const lds_cptr shm3=(lds_cptr)shm; const lds_cptr kp0=shm3+LDS_K+hi*1024+r32*16; const lds_cptr vp0=shm3+LDS_V+((lane>>4)&1)*32+(lane&3)*8+(4*hi+((lane&15)>>2))*64;
  const int NT=NTILES;
  DMA_K(0,0);DMA_V(0,0);DMA_K(1,SLOTB);
  bf16x8 qr[4];
  #pragma unroll
  for(int d0=0;d0<4;++d0)qr[d0]=*reinterpret_cast<const bf16x8*>(&Qw[(long)r32*QP+d0*16+hi*8]);
  float mhat=0.f,l_reg=0.f;f32x16 o[2];o[0]=f32x16{};o[1]=f32x16{};f32x16 negm=f32x16{};asm volatile("":"+v"(negm));
  const int qrel=wid*QBLK+r32;
  #define CMASK(P0,P1,t) do{}while(0)
  bool resc=false;
  #define START(P0,P1) do{ const float rm=rowmax(P0,P1); resc=false; \
    { const float dl=rm; mhat=fadd_s(mhat,dl); \
      _Pragma("unroll") for(int r=0;r<16;++r){P0[r]=fsub_s(P0[r],dl);P1[r]=fsub_s(P1[r],dl);} \
      _Pragma("unroll") for(int r=0;r<16;++r)negm[r]=-mhat; asm volatile("":"+v"(negm)); } \
    _Pragma("unroll") for(int r=0;r<16;++r)P0[r]=__builtin_amdgcn_exp2f(P0[r]); }while(0)
  #define RESC() do{ if(resc){ asm volatile("s_waitcnt lgkmcnt(0)":::"memory"); \
      _Pragma("unroll") for(int d_=0;d_<2;++d_) _Pragma("unroll") for(int r=0;r<16;++r)o[d_][r]*=wsf[crow(r,hi)]; } }while(0)
  f32x16 pA0,pA1,pB0,pB1;
  int sl_prev=0,sl_cur=0,sl_next=SLOTB;
  #define ROT() do{sl_prev=sl_cur;sl_cur=sl_next;sl_next=(sl_next==(NSLOT-1)*SLOTB)?0:sl_next+SLOTB;}while(0)
  DMA_K(2,2*SLOTB);
  WAIT_BAR(3);
  qkt(pA0,pA1,Kbase,qr,negm,r32,hi);asm volatile("s_nop 15\n\ts_nop 7":"+v"(pA0),"+v"(pA1));CMASK(pA0,pA1,0);
  START(pA0,pA1);
  _Pragma("unroll") for(int r=0;r<16;++r)pA1[r]=__builtin_amdgcn_exp2f(pA1[r]);
  WAIT_BAR(0);
  DMA_K(3,0);DMA_V(1,SLOTB);
  ROT();
  kload8(kf,kp0+sl_cur);
  WAIT_BAR(2);
  s16x4 vlo[8],vhi[8]; u32x4 pw0,pw1,pw2,pw3;
  #define PKW(P,B) cvtpk_s(P[B],P[B+1])
  #define PAF(k) __builtin_bit_cast(bf16x8,pw##k)
  #define VFR(i) (bf16x8){vlo[i][0],vlo[i][1],vlo[i][2],vlo[i][3],vhi[i][0],vhi[i][1],vhi[i][2],vhi[i][3]}
  #define PIN(x) asm volatile("":"+v"(x))
  #define MX3(a,b,c) __builtin_fmaxf(__builtin_fmaxf((a),(b)),(c))
  #define GAPA(MF,A0,A1,A2,A3,W0,W1,PW) do{ MF; sacc+=A0; sacc+=A1; sacc+=A2; sacc+=A3; PIN(sacc); W0; W1; PIN(PW); SBAR(); }while(0)
  #define EX(v) __builtin_amdgcn_exp2f(v)
  #define GAPB(MF,X,B) do{ MF; X[B]=EX(X[B]); X[B+1]=EX(X[B+1]); X[B+2]=EX(X[B+2]); X[B+3]=EX(X[B+3]); PIN(X); SBAR(); }while(0)
  #define VRD(i) do{ vlo[i]=vtr(vp_+(((i)>>2)*4096+((i)&3)*1024)); vhi[i]=vtr(vp_+(((i)>>2)*4096+((i)&3)*1024+512)); }while(0)
  #define KRD(G,j) do{ if(G){ kload2(kf,kp0+sl_next,j); SBAR(); } }while(0)
  #define STEP(C0,C1,P0,P1,t,GK,GV,GL) do{ SBAR(); \
    const lds_cptr vp_=vp0+sl_prev; \
    VRD(0); SBAR(); float sacc=(P0[0]+P0[1]); \
    GAPA(C0=__builtin_amdgcn_mfma_f32_32x32x16_bf16(kf[0],qr[0],negm,0,0,0), P0[2],P0[3],P0[4],P0[5],     pw0[0]=PKW(P0,0), pw0[1]=PKW(P0,2), pw0); \
    VRD(4); SBAR(); GAPA(C1=__builtin_amdgcn_mfma_f32_32x32x16_bf16(kf[1],qr[0],negm,0,0,0), P0[6],P0[7],P0[8],P0[9],     pw0[2]=PKW(P0,4), pw0[3]=PKW(P0,6), pw0); \
    VRD(1); SBAR(); GAPA(C0=__builtin_amdgcn_mfma_f32_32x32x16_bf16(kf[2],qr[1],C0,0,0,0),   P0[10],P0[11],P0[12],P0[13], pw1[0]=PKW(P0,8), pw1[1]=PKW(P0,10), pw1); \
    VRD(5); SBAR(); GAPA(C1=__builtin_amdgcn_mfma_f32_32x32x16_bf16(kf[3],qr[1],C1,0,0,0),   P0[14],P0[15],P1[0],P1[1],   pw1[2]=PKW(P0,12),pw1[3]=PKW(P0,14), pw1); \
    VRD(2); SBAR(); GAPA(C0=__builtin_amdgcn_mfma_f32_32x32x16_bf16(kf[4],qr[2],C0,0,0,0),   P1[2],P1[3],P1[4],P1[5],     pw2[0]=PKW(P1,0), pw2[1]=PKW(P1,2), pw2); \
    VRD(6); SBAR(); GAPA(C1=__builtin_amdgcn_mfma_f32_32x32x16_bf16(kf[5],qr[2],C1,0,0,0),   P1[6],P1[7],P1[8],P1[9],     pw2[2]=PKW(P1,4), pw2[3]=PKW(P1,6), pw2); \
    VRD(3); SBAR(); GAPA(C0=__builtin_amdgcn_mfma_f32_32x32x16_bf16(kf[6],qr[3],C0,0,0,0),   P1[10],P1[11],P1[12],P1[13], pw3[0]=PKW(P1,8), pw3[1]=PKW(P1,10), pw3); \
    VRD(7); SBAR(); GAPA(C1=__builtin_amdgcn_mfma_f32_32x32x16_bf16(kf[7],qr[3],C1,0,0,0),   P1[14],P1[15],0.f,0.f,       pw3[2]=PKW(P1,12),pw3[3]=PKW(P1,14), pw3); \
    l_reg+=sacc; \
    if(GK){DMA_K((t)+3,sl_cur);} if(GV){DMA_V((t)+1,sl_next);} \
    CMASK(C0,C1,t); \
    { float a=MX3(C0[0],C0[1],C1[0]),b=MX3(C0[2],C0[3],C1[1]); a=MX3(a,C1[2],C1[3]); \
      _Pragma("unroll") for(int r=4;r<16;r+=4){a=MX3(a,C0[r],C0[r+1]);b=MX3(b,C0[r+2],C0[r+3]);a=MX3(a,C1[r],C1[r+1]);b=MX3(b,C1[r+2],C1[r+3]);} \
      float rm=__builtin_fmaxf(a,b); { auto rr=__builtin_amdgcn_permlane32_swap(__float_as_uint(rm),__float_as_uint(rm),false,false); rm=__builtin_fmaxf(__uint_as_float(rr[0]),__uint_as_float(rr[1])); } \
      resc=false; \
      if(__builtin_expect(__any(rm>(float)THRL),0)){ const float dl=__builtin_fmaxf(rm,0.f); mhat+=dl; \
        _Pragma("unroll") for(int r=0;r<16;++r){C0[r]-=dl;C1[r]-=dl;} \
        _Pragma("unroll") for(int r=0;r<16;++r)negm[r]=-mhat; asm volatile("":"+v"(negm)); \
        const float f=__builtin_amdgcn_exp2f(-dl); l_reg*=f; if(hi==0)wsf[r32]=f; resc=true; } } \
    SBAR(); \
    GAPB(o[0]=__builtin_amdgcn_mfma_f32_32x32x16_bf16(PAF(0),VFR(0),o[0],0,0,0), C0,0); \
    GAPB(o[1]=__builtin_amdgcn_mfma_f32_32x32x16_bf16(PAF(0),VFR(4),o[1],0,0,0), C0,4); \
    KRD(GL,0); GAPB(o[0]=__builtin_amdgcn_mfma_f32_32x32x16_bf16(PAF(1),VFR(1),o[0],0,0,0), C0,8); \
    KRD(GL,1); GAPB(o[1]=__builtin_amdgcn_mfma_f32_32x32x16_bf16(PAF(1),VFR(5),o[1],0,0,0), C0,12); \
    KRD(GL,2); GAPB(o[0]=__builtin_amdgcn_mfma_f32_32x32x16_bf16(PAF(2),VFR(2),o[0],0,0,0), C1,0); \
    KRD(GL,3); GAPB(o[1]=__builtin_amdgcn_mfma_f32_32x32x16_bf16(PAF(2),VFR(6),o[1],0,0,0), C1,4); \
    GAPB(o[0]=__builtin_amdgcn_mfma_f32_32x32x16_bf16(PAF(3),VFR(3),o[0],0,0,0), C1,8); \
    GAPB(o[1]=__builtin_amdgcn_mfma_f32_32x32x16_bf16(PAF(3),VFR(7),o[1],0,0,0), C1,12); \
    }while(0)
  int t=1;
  #undef CMASK
  #define CMASK(P0,P1,t) do{}while(0)
  for(;t+5<NT;t+=2){
    STEP(pB0,pB1,pA0,pA1,t,true,true,true);     WAIT_BAR(2); RESC(); ROT();
    STEP(pA0,pA1,pB0,pB1,t+1,true,true,true);   WAIT_BAR(2); RESC(); ROT();
  }
  #undef CMASK
  #define CMASK(P0,P1,t) do{}while(0)
  #define ENDW(tt) do{ if((tt)+3<NT){WAIT_BAR(2);} else if((tt)+2<NT){WAIT_BAR(1);} else {WAIT_BAR(0);} }while(0)
  for(;t+1<NT;t+=2){
    STEP(pB0,pB1,pA0,pA1,t,(t+3<NT),(t+1<NT),(t+1<NT));       ENDW(t);   RESC(); ROT();
    STEP(pA0,pA1,pB0,pB1,t+1,(t+4<NT),(t+2<NT),(t+2<NT));     ENDW(t+1); RESC(); ROT();
  }
  STEP(pB0,pB1,pA0,pA1,NT-1,false,false,false); RESC();
  { float sacc=pB0[0]+pB0[1]; _Pragma("unroll") for(int r=2;r<16;++r)sacc+=pB0[r]; _Pragma("unroll") for(int r=0;r<16;++r)sacc+=pB1[r]; l_reg+=sacc;
    pw0=(u32x4){PKW(pB0,0),PKW(pB0,2),PKW(pB0,4),PKW(pB0,6)};pw1=(u32x4){PKW(pB0,8),PKW(pB0,10),PKW(pB0,12),PKW(pB0,14)};pw2=(u32x4){PKW(pB1,0),PKW(pB1,2),PKW(pB1,4),PKW(pB1,6)};pw3=(u32x4){PKW(pB1,8),PKW(pB1,10),PKW(pB1,12),PKW(pB1,14)};
    SBAR(); pv(o,vb0+sl_cur,PAF(0),PAF(1),PAF(2),PAF(3)); }
  #undef PKW
  #undef PAF
  #undef VFR
  #undef PIN
  #undef MX3
  #undef GAPA
  #undef GAPB
  #undef EX
  #undef VRD
  #undef KRD
  #undef STEP
  #undef ENDW
  {auto rr=__builtin_amdgcn_permlane32_swap(__float_as_uint(l_reg),__float_as_uint(l_reg),false,false);l_reg=__uint_as_float(rr[0])+__uint_as_float(rr[1]);}
  if(hi==0)wsf[32+r32]=l_reg;asm volatile("s_waitcnt lgkmcnt(0)":::"memory");
  float rli[16];
  #pragma unroll
  for(int r=0;r<16;++r)rli[r]=__builtin_amdgcn_rcpf(wsf[32+crow(r,hi)]);
  bf16*Ow=O+(long)(q0+wid*QBLK)*OP;
  { bf16*stg=(bf16*)(shm+LDS_OST)+wid*2048;
    #pragma unroll
    for(int r=0;r<16;++r){const int orow=crow(r,hi);
      #pragma unroll
      for(int d0=0;d0<2;++d0)stg[orow*64+d0*32+r32]=__float2bfloat16(o[d0][r]*rli[r]);}
    asm volatile("s_waitcnt lgkmcnt(0)":::"memory");
    #pragma unroll
    for(int i=0;i<4;++i){const int row=i*8+(lane>>3),ch=lane&7; const u32x4 v=*(const u32x4*)(stg+row*64+ch*8); ATTN_STORE16(Ow+(long)row*OP+ch*8,v);} }
  asm volatile("s_waitcnt lgkmcnt(0)\n\ts_barrier":::"memory");
  #undef DMA_K
  #undef DMA_V
  #undef CMASK
  #undef START
  #undef RESC
  #undef ROT
}
constexpr int ATTN_LDS_BYTES=LDS_BYTES;
struct AttnTensors { const bf16* Q; const bf16* K; const bf16* V; bf16* O; };
struct AttnUnit { int bh; int qb; };
}
#define LAS __attribute__((address_space(3)))
typedef unsigned short bf16_t;
typedef short bf16x8 __attribute__((ext_vector_type(8)));
typedef short s16x4 __attribute__((ext_vector_type(4)));
typedef float f32x4 __attribute__((ext_vector_type(4)));
typedef float f32x16 __attribute__((ext_vector_type(16)));
typedef unsigned u32x4 __attribute__((ext_vector_type(4)));
typedef unsigned u32x2 __attribute__((ext_vector_type(2)));

#define XB_TMO      128
#define XB_XCNT(j)  (256  + 64 * (j))
#define XB_XSUB(j)  (1280 + 64 * (j))
#define XB_XGEN(j)  (2304 + 64 * (j))
#define XB_TOP      3328
#define XB_TOPGEN   3392
#define XCD_BAR_WORDS 3456
#define XB_SPIN_CAP (1u << 18)

__device__ __forceinline__ unsigned xb_ld(unsigned* p)              { return __hip_atomic_load(p, __ATOMIC_RELAXED, __HIP_MEMORY_SCOPE_AGENT); }
__device__ __forceinline__ unsigned xb_add(unsigned* p, unsigned v) { return __hip_atomic_fetch_add(p, v, __ATOMIC_RELAXED, __HIP_MEMORY_SCOPE_AGENT); }
__device__ __forceinline__ unsigned xb_xcc_id() { return (unsigned)__builtin_amdgcn_s_getreg((3 << 11) | 20) & 0xFu; }
#define XB_SPIN(cond, bar) do { unsigned _sp = 0; while (cond) { __builtin_amdgcn_s_sleep(1); \
    if ((++_sp & 255u) == 0u) { if (xb_ld(&(bar)[XB_TMO])) break; if (_sp > XB_SPIN_CAP) { atomicAdd(&(bar)[XB_TMO], 1u); break; } } } } while (0)

struct XcdBarrier {
    unsigned* bar; unsigned x;
    volatile LAS unsigned* st;
};

__device__ __forceinline__ XcdBarrier xcd_barrier_post(unsigned* bar, volatile LAS unsigned* st, int tid) {
    XcdBarrier b; b.bar = bar; b.x = xb_xcc_id(); b.st = st;
    if (tid == 0) (void)xb_add(&bar[XB_XCNT(b.x)], 1u);
    return b;
}
__device__ __forceinline__ void xcd_barrier_complete(unsigned* bar, unsigned x, unsigned& nloc, unsigned& nx) {
    const unsigned G = gridDim.x * gridDim.y * gridDim.z;
    unsigned sum, cnt, mine, sp = 0u;
    for (;;) {
        sum = 0u; cnt = 0u; mine = 0u;
#pragma unroll
        for (unsigned j = 0; j < 16; ++j) { const unsigned c = xb_ld(&bar[XB_XCNT(j)]); sum += c; cnt += (c > 0u) ? 1u : 0u; mine = (j == x) ? c : mine; }
        if (sum == G) break;
        __builtin_amdgcn_s_sleep(1);
        if ((++sp & 255u) == 0u) { if (xb_ld(&bar[XB_TMO])) break; if (sp > XB_SPIN_CAP) { atomicAdd(&bar[XB_TMO], 1u); break; } }
    }
    nloc = mine > 0u ? mine : 1u; nx = cnt > 0u ? cnt : 1u;
}

__device__ __forceinline__ void xcd_barrier(const XcdBarrier& b, int tid) {
    asm volatile("s_waitcnt vmcnt(0)" ::: "memory");
    __syncthreads();
    if (tid == 0) {
        unsigned* bar = b.bar;
        __builtin_amdgcn_s_waitcnt(0);
        unsigned nloc = b.st[0], nx = b.st[1];
        if (nloc == 0u) { xcd_barrier_complete(bar, b.x, nloc, nx); b.st[0] = nloc; b.st[1] = nx; }
        const unsigned old = xb_add(&bar[XB_XSUB(b.x)], 1u);
        const unsigned gen = old / nloc;
        if (old + 1u == (gen + 1u) * nloc) {
            __builtin_amdgcn_fence(__ATOMIC_RELEASE, "agent");
            asm volatile("s_waitcnt vmcnt(0)" ::: "memory");
            const unsigned og = xb_add(&bar[XB_TOP], 1u);
            const unsigned tg = og / nx;
            if (og + 1u == (tg + 1u) * nx) xb_add(&bar[XB_TOPGEN], 1u);
            else XB_SPIN(xb_ld(&bar[XB_TOPGEN]) == tg, bar);
            __builtin_amdgcn_fence(__ATOMIC_ACQUIRE, "agent");
            xb_add(&bar[XB_XGEN(b.x)], 1u);
            asm volatile("s_waitcnt vmcnt(0)" ::: "memory");
        } else {
            XB_SPIN(xb_ld(&bar[XB_XGEN(b.x)]) == gen, bar);
            __builtin_amdgcn_fence(__ATOMIC_ACQUIRE, "agent");
            asm volatile("s_waitcnt vmcnt(0)" ::: "memory");
        }
    }
    __syncthreads();
}

constexpr int S_LAT = 16384, N_CTX = 256, MT = 16640, DM = 1024, N_EVEN = 2304, N_ODD = 1280, FF = 2816, NU = 5632, NMOD = 6144;
constexpr float DN_ALPHA = 1.6817928305074290f, LOG2E = 1.4426950408889634f, QC2 = 0.125f * 1.4426950408889634f, LN_EPS = 1e-5f;
constexpr size_t MiB = 1u << 20;
constexpr size_t WS_MODS = 0, WS_BAR = 224 * 1024  , WS_ROPE = 256 * 1024, WS_WIN = 1 * MiB, WS_WOUT = 6 * MiB, WS_WUP = 8 * MiB, WS_WDN = 19 * MiB, WS_XS = 25 * MiB, WS_R1 = 90 * MiB, WS_O = WS_R1 + 74 * MiB,
                 WS_XN = 201 * MiB  , WS_HF2 = 236 * MiB, WS_PART = 359 * MiB, WS_END = 371 * MiB;
static_assert((size_t)MT * N_EVEN * 2 <= 74 * MiB && WS_O + (size_t)MT * DM * 2 <= WS_XN - MiB && WS_XN + (size_t)(MT + 512) * DM * 2 <= WS_HF2 && WS_HF2 + (size_t)MT * FF * 2 <= WS_PART, "ws map");
constexpr int LDS_BYTES = 147456 + 64, LDS_BARST = 147456;

struct Args { const float* in[20]; float* out; unsigned char* ws; };
typedef const __attribute__((address_space(4))) Args* ArgsP;
__device__ __forceinline__ ArgsP relaunder(ArgsP p) { asm volatile("" : "+s"(p)); return p; }

__device__ __forceinline__ unsigned pk2(float lo, float hi) { return pg8::pk_bf16(lo, hi); }
__device__ __forceinline__ float bf_lo(unsigned w) { return __uint_as_float(w << 16); }
__device__ __forceinline__ float bf_hi(unsigned w) { return __uint_as_float(w & 0xffff0000u); }
__device__ __forceinline__ float wave_sum(float v) {
#pragma unroll
    for (int o = 1; o < 64; o <<= 1) v += __shfl_xor(v, o);
    return v;
}
__device__ __forceinline__ float silu_f(float v) { return v / (1.0f + __expf(-v)); }

template <int KIND> __device__ __forceinline__ int cmap(int cp) {
    if (KIND == 0) return cp;
    if (KIND == 3) { const int pn = cp >> 8, bj = (cp >> 7) & 1, x = cp & 127; return FF * bj + 128 * pn + x; }
    const int pn = cp >> 8, bj = (cp >> 7) & 1, wc = (cp >> 5) & 3, p = cp & 31, hb = 256 * pn + 64 * wc;
    const bool rope = hb < (KIND == 1 ? 640 : 1152);
    const int d32 = rope ? (16 * ((p >> 2) & 1) + 4 * (p >> 3) + (p & 3)) : p;
    return hb + 32 * bj + d32;
}
template <int KIND> __device__ __forceinline__ void transpose_item(const float* W, int K, int N, bf16_t* WT, LAS float* scr, int item, int lane) {
    const int nblk = N / 32, kb = item / nblk, nb = item % nblk, k0 = 64 * kb, n0 = 32 * nb;
    const int o0 = cmap<KIND>(n0) & ~31;
#pragma unroll 8
    for (int i = 0; i < 32; ++i) { const int kk = 2 * i + (lane >> 5); scr[kk * 33 + (lane & 31)] = W[(size_t)(k0 + kk) * N + o0 + (lane & 31)]; }
    asm volatile("s_waitcnt lgkmcnt(0)" ::: "memory");
    const int c = lane & 7;
#pragma unroll
    for (int j = 0; j < 4; ++j) { const int n = (lane >> 3) + 8 * j; const int sidx = cmap<KIND>(n0 + n) - o0; const LAS float* s = scr + (8 * c) * 33 + sidx;
        u32x4 o; o.x = pk2(s[0 * 33], s[1 * 33]); o.y = pk2(s[2 * 33], s[3 * 33]); o.z = pk2(s[4 * 33], s[5 * 33]); o.w = pk2(s[6 * 33], s[7 * 33]);
        *(u32x4*)(WT + (size_t)(n0 + n) * K + k0 + 8 * c) = o; }
    asm volatile("s_waitcnt lgkmcnt(0)" ::: "memory");
}
__device__ __forceinline__ void convert_layer(ArgsP a, int l, LAS unsigned char* lds, int gw, int ngw, int wave, int lane) {
    LAS float* scr = (LAS float*)(lds + wave * 16384);
    unsigned char* ws = a->ws;
    const int i = l >> 1; const bool odd = l & 1;
    const int n_in = odd ? N_ODD : N_EVEN;
    const float* w_in = odd ? a->in[13] + (size_t)i * DM * N_ODD : a->in[8] + (size_t)i * DM * N_EVEN;
    const float* w_out = (odd ? a->in[14] : a->in[9]) + (size_t)i * DM * DM;
    const float* w_up = a->in[16] + (size_t)l * DM * NU;
    const float* w_dn = a->in[19] + (size_t)l * FF * DM;
    const int I_IN = (DM / 64) * (n_in / 32), I_OUT = (DM / 64) * (DM / 32), I_UP = (DM / 64) * (NU / 32), I_DN = (FF / 64) * (DM / 32);
    const int total = I_IN + I_OUT + I_UP + I_DN;
    for (int it = gw; it < total; it += ngw) {
        int r = it;
        if (r < I_IN) { if (odd) transpose_item<2>(w_in, DM, n_in, (bf16_t*)(ws + WS_WIN), scr, r, lane); else transpose_item<1>(w_in, DM, n_in, (bf16_t*)(ws + WS_WIN), scr, r, lane); continue; } r -= I_IN;
        if (r < I_OUT) { transpose_item<0>(w_out, DM, DM, (bf16_t*)(ws + WS_WOUT), scr, r, lane); continue; } r -= I_OUT;
        if (r < I_UP) { transpose_item<3>(w_up, DM, NU, (bf16_t*)(ws + WS_WUP), scr, r, lane); continue; } r -= I_UP;
        transpose_item<0>(w_dn, FF, DM, (bf16_t*)(ws + WS_WDN), scr, r, lane);
    }
}

__device__ __forceinline__ void phase_adaln(ArgsP a, LAS unsigned char* lds, int bid, int G, int tid, int wave, int lane) {
    LAS float* red = (LAS float*)(lds + 8 * 16384);
    const float* c = a->in[1]; const float* cc = a->in[3]; const float* ada_w = a->in[4]; const float* ada_b = a->in[5];
    float* mods = (float*)(a->ws + WS_MODS);
    for (int task = bid; task < 96; task += G) {
        const int l = task / 24, cgp = task % 24;
        const float* W = ada_w + (size_t)l * DM * NMOD + cgp * 256 + 4 * lane;
        f32x4 a0 = {0.f, 0.f, 0.f, 0.f}, a1 = {0.f, 0.f, 0.f, 0.f};
#pragma unroll 8
        for (int kk = 0; kk < 128; ++kk) { const int k = wave * 128 + kk; const float s0 = silu_f(c[k]), s1 = silu_f(cc[k]);
            const f32x4 w = *(const f32x4*)(W + (size_t)k * NMOD); a0 += w * s0; a1 += w * s1; }
#pragma unroll
        for (int j = 0; j < 4; ++j) { red[(wave * 2 + 0) * 256 + 4 * lane + j] = a0[j]; red[(wave * 2 + 1) * 256 + 4 * lane + j] = a1[j]; }
        __syncthreads();
        { const int v = tid >> 8, col = tid & 255; float s = 0.f;
#pragma unroll
          for (int w = 0; w < 8; ++w) s += red[(w * 2 + v) * 256 + col];
          mods[(size_t)(l * 2 + v) * NMOD + cgp * 256 + col] = s + ada_b[l * NMOD + cgp * 256 + col]; }
        __syncthreads();
    }
}
__device__ __forceinline__ void rope_tables(ArgsP a, int tid) {
    float* cosT = (float*)(a->ws + WS_ROPE); float* sinT = cosT + 4096;
    for (int idx = tid; idx < 4096; idx += 512) { const int pos = idx >> 4, i = idx & 15;
        const float f = exp2f(-(float)i * (13.287712379549449f / 16.0f)); const float ang = (float)pos * f;
        cosT[idx] = __cosf(ang); sinT[idx] = __sinf(ang); }
}
__device__ __forceinline__ void phase_init(ArgsP a, int gw, int ngw, int lane) {
    float* XS = (float*)(a->ws + WS_XS); bf16_t* XN = (bf16_t*)(a->ws + WS_XN); const float* mods = (const float*)(a->ws + WS_MODS);
    for (int r = gw; r < MT; r += ngw) {
        const bool isc = r >= S_LAT; const float* src = isc ? a->in[2] + (size_t)(r - S_LAT) * DM : a->in[0] + (size_t)r * DM;
        const float* mv = mods + (isc ? NMOD : 0);
#pragma unroll
        for (int j = 0; j < 4; ++j) { const int c0 = 4 * lane + 256 * j; const f32x4 x = *(const f32x4*)(src + c0), sh = *(const f32x4*)(mv + c0), sc = *(const f32x4*)(mv + DM + c0);
            *(f32x4*)(XS + (size_t)r * DM + c0) = x * DN_ALPHA; const f32x4 h = x * (sc + 1.0f) + sh;
            u32x2 w; w.x = pk2(h[0], h[1]); w.y = pk2(h[2], h[3]); *(u32x2*)(XN + (size_t)r * DM + c0) = w; }
    }
}
__device__ __forceinline__ void phase_ln(ArgsP a, int nrows, int npart, const float* gate_ctx, const float* g, const float* b, const float* mod_lat  , float* dout, int gw, int ngw, int lane) {
    float* XS = (float*)(a->ws + WS_XS); bf16_t* XN = (bf16_t*)(a->ws + WS_XN);
    for (int r = gw; r < nrows; r += ngw) {
        const float* zr = XS + (size_t)r * DM;
        f32x4 v[4]; float s = 0.f;
#pragma unroll
        for (int j = 0; j < 4; ++j) v[j] = *(const f32x4*)(zr + 4 * lane + 256 * j);
        if (r >= S_LAT) { const float* pr = (const float*)(a->ws + WS_PART) + (size_t)(r - S_LAT) * DM + 4 * lane;
            f32x4 ps[4];
#pragma unroll
            for (int j = 0; j < 4; ++j) ps[j] = (f32x4){0.f, 0.f, 0.f, 0.f};
            for (int kc = 0; kc < npart; ++kc) {
#pragma unroll
                for (int j = 0; j < 4; ++j) ps[j] += *(const f32x4*)(pr + (size_t)kc * 256 * DM + 256 * j); }
#pragma unroll
            for (int j = 0; j < 4; ++j) v[j] += ps[j] * *(const f32x4*)(gate_ctx + 4 * lane + 256 * j); }
#pragma unroll
        for (int j = 0; j < 4; ++j) s += (v[j][0] + v[j][1]) + (v[j][2] + v[j][3]);
        const float mean = wave_sum(s) * (1.0f / DM); float s2 = 0.f;
#pragma unroll
        for (int j = 0; j < 4; ++j) { v[j] = v[j] - mean; s2 += (v[j][0] * v[j][0] + v[j][1] * v[j][1]) + (v[j][2] * v[j][2] + v[j][3] * v[j][3]); }
        const float rstd = 1.0f / sqrtf(wave_sum(s2) * (1.0f / DM) + LN_EPS);
        const float* mv = mod_lat ? mod_lat + (r >= S_LAT ? NMOD : 0) : nullptr;
#pragma unroll
        for (int j = 0; j < 4; ++j) { const int c0 = 4 * lane + 256 * j; const f32x4 x = v[j] * rstd * *(const f32x4*)(g + c0) + *(const f32x4*)(b + c0);
            if (dout) *(f32x4*)(dout + (size_t)r * DM + c0) = x;
            else { *(f32x4*)(XS + (size_t)r * DM + c0) = x * DN_ALPHA;
                const f32x4 h = x * (*(const f32x4*)(mv + DM + c0) + 1.0f) + *(const f32x4*)(mv + c0);
                u32x2 w; w.x = pk2(h[0], h[1]); w.y = pk2(h[2], h[3]); *(u32x2*)(XN + (size_t)r * DM + c0) = w; } }
    }
}
typedef short v4i16_t __attribute__((ext_vector_type(4)));
template <int MODE>
__device__ __forceinline__ void wave_attn(const bf16_t* Q, const bf16_t* K, const bf16_t* V, bf16_t* O, int pitch, int qtok, int nloc, int kbase, int kstride,
                                          const LAS float* rpb, bool has_sink, float sink_l2, LAS unsigned char* vl, int lane) {
    const int r32 = lane & 31, hi = lane >> 5;
    bf16x8 qr[4];
    { const bf16_t* qp = Q + (size_t)qtok * pitch + 8 * hi;
#pragma unroll
      for (int d0 = 0; d0 < 4; ++d0) qr[d0] = *(const bf16x8*)(qp + 16 * d0); }
    float m = -1e30f, l = 0.f;
    f32x16 o0, o1;
#pragma unroll
    for (int r = 0; r < 16; ++r) { o0[r] = 0.f; o1[r] = 0.f; }
    const int ntile = nloc + 8;
    const int qrow = qtok >> 6, qcol = qtok & 63;
    const int rs_q = min(max(qrow - 4, 0), 248), cs_q = min(max(qcol - 8, 0), 48);
    bf16x8 kfn[4], vn[4];
    { const int kt = nloc > 0 ? kbase : S_LAT;
      const bf16_t* kp = K + (size_t)(kt + r32) * pitch + 8 * hi; const bf16_t* vp = V + (size_t)(kt + (lane >> 1)) * pitch + (lane & 1) * 32;
#pragma unroll
      for (int d0 = 0; d0 < 4; ++d0) { kfn[d0] = *(const bf16x8*)(kp + 16 * d0); vn[d0] = *(const bf16x8*)(vp + 8 * d0); } }
    const LAS unsigned char* vb = vl + (4 * hi + ((lane & 15) >> 2)) * 144 + ((lane >> 4) & 1) * 32 + (lane & 3) * 8;
    LAS unsigned char* vdst = vl + (lane >> 1) * 144 + (lane & 1) * 64;
    for (int u = 0; u < ntile; ++u) {
        bf16x8 kf[4], vr[4];
#pragma unroll
        for (int d0 = 0; d0 < 4; ++d0) { kf[d0] = kfn[d0]; vr[d0] = vn[d0]; }
        if (u + 1 < ntile) {
            const int kt = (u + 1 < nloc) ? kbase + kstride * (u + 1) : S_LAT + 32 * (u + 1 - nloc);
            const bf16_t* kp = K + (size_t)(kt + r32) * pitch + 8 * hi; const bf16_t* vp = V + (size_t)(kt + (lane >> 1)) * pitch + (lane & 1) * 32;
#pragma unroll
            for (int d0 = 0; d0 < 4; ++d0) { kfn[d0] = *(const bf16x8*)(kp + 16 * d0); vn[d0] = *(const bf16x8*)(vp + 8 * d0); }
        }
        asm volatile("" ::: "memory");
#pragma unroll
        for (int d0 = 0; d0 < 4; ++d0) *(LAS bf16x8*)(vdst + 16 * d0) = vr[d0];
        f32x16 s;
#pragma unroll
        for (int r = 0; r < 16; ++r) s[r] = 0.f;
#pragma unroll
        for (int d0 = 0; d0 < 4; ++d0) s = __builtin_amdgcn_mfma_f32_32x32x16_bf16(kf[d0], qr[d0], s, 0, 0, 0);
        if (MODE != 2 && u < nloc) {
            if (MODE == 0) {
                const int kr = (kbase >> 6) + u, c0 = kbase & 63;
                const bool rowok = (kr >= rs_q) && (kr < rs_q + 8);
                const int ib = (kr - qrow + 7) * 31 + (c0 - qcol + 15);
#pragma unroll
                for (int r = 0; r < 16; ++r) { const int kvl = (r & 3) + 8 * (r >> 2) + 4 * hi; const int kc = c0 + kvl;
                    const bool ok = rowok && (kc >= cs_q) && (kc < cs_q + 16);
                    const float bias = rpb[ok ? ib + kvl : 0];
                    s[r] = ok ? s[r] + bias : -1e30f; }
            } else {
                const int d0k = kbase + kstride * u - qtok;
#pragma unroll
                for (int r = 0; r < 16; ++r) { const int dd = d0k + (r & 3) + 8 * (r >> 2) + 4 * hi; s[r] = (dd >= -128 && dd <= 128) ? s[r] : -1e30f; }
            }
        }
        float tm = s[0];
#pragma unroll
        for (int r = 1; r < 16; ++r) tm = fmaxf(tm, s[r]);
        tm = fmaxf(tm, __shfl_xor(tm, 32));
        const float mn = fmaxf(m, tm), al = __builtin_amdgcn_exp2f(m - mn); m = mn;
        float rsum = 0.f;
#pragma unroll
        for (int r = 0; r < 16; ++r) { s[r] = __builtin_amdgcn_exp2f(s[r] - mn); rsum += s[r]; }
        l = l * al + rsum;
#pragma unroll
        for (int r = 0; r < 16; ++r) { o0[r] *= al; o1[r] *= al; }
        u32x4 w0, w1;
        w0.x = pk2(s[0], s[1]); w0.y = pk2(s[2], s[3]); w0.z = pk2(s[4], s[5]); w0.w = pk2(s[6], s[7]);
        w1.x = pk2(s[8], s[9]); w1.y = pk2(s[10], s[11]); w1.z = pk2(s[12], s[13]); w1.w = pk2(s[14], s[15]);
        const bf16x8 pf0 = __builtin_bit_cast(bf16x8, w0), pf1 = __builtin_bit_cast(bf16x8, w1);
        asm volatile("s_waitcnt lgkmcnt(0)" ::: "memory");
#pragma unroll
        for (int s2 = 0; s2 < 2; ++s2) {
#pragma unroll
            for (int d0 = 0; d0 < 2; ++d0) {
                const s16x4 lo = __builtin_bit_cast(s16x4, __builtin_amdgcn_ds_read_tr16_b64_v4i16((LAS v4i16_t*)(vb + (16 * s2) * 144 + d0 * 64)));
                const s16x4 hh = __builtin_bit_cast(s16x4, __builtin_amdgcn_ds_read_tr16_b64_v4i16((LAS v4i16_t*)(vb + (16 * s2 + 8) * 144 + d0 * 64)));
                const bf16x8 vf = {lo[0], lo[1], lo[2], lo[3], hh[0], hh[1], hh[2], hh[3]};
                if (d0 == 0) o0 = __builtin_amdgcn_mfma_f32_32x32x16_bf16(vf, s2 ? pf1 : pf0, o0, 0, 0, 0);
                else         o1 = __builtin_amdgcn_mfma_f32_32x32x16_bf16(vf, s2 ? pf1 : pf0, o1, 0, 0, 0);
            }
        }
        asm volatile("s_waitcnt lgkmcnt(0)" ::: "memory");
    }
    if (has_sink) { const float mn = fmaxf(m, sink_l2), al = __builtin_amdgcn_exp2f(m - mn); l = l * al + (hi == 0 ? __builtin_amdgcn_exp2f(sink_l2 - mn) : 0.f);
#pragma unroll
        for (int r = 0; r < 16; ++r) { o0[r] *= al; o1[r] *= al; } }
    l += __shfl_xor(l, 32);
    const float inv = 1.0f / l;
    bf16_t* op = O + (size_t)qtok * DM + 4 * hi;
#pragma unroll
    for (int g = 0; g < 4; ++g) {
        u32x2 wa, wb; wa.x = pk2(o0[4 * g] * inv, o0[4 * g + 1] * inv); wa.y = pk2(o0[4 * g + 2] * inv, o0[4 * g + 3] * inv);
        wb.x = pk2(o1[4 * g] * inv, o1[4 * g + 1] * inv); wb.y = pk2(o1[4 * g + 2] * inv, o1[4 * g + 3] * inv);
        *(u32x2*)(op + 8 * g) = wa; *(u32x2*)(op + 32 + 8 * g) = wb;
    }
}
__device__ __forceinline__ void phase_attn_waves(ArgsP a, int l, bool ctx_out, LAS unsigned char* lds, int gw, int ngw, int wave, int lane) {
    const bool odd = l & 1; const int li = l >> 1;
    const bf16_t* QKV = (const bf16_t*)(a->ws + WS_R1); bf16_t* OB = (bf16_t*)(a->ws + WS_O);
    const LAS float* rpbL = (const LAS float*)lds;
    LAS unsigned char* vl = lds + 16384 + wave * 4608;
    const int r32 = lane & 31;
    const int nmain = odd ? 8192 : 4096, total = nmain + (ctx_out ? 128 : 0);
    for (int idx = gw; idx < total; idx += ngw) {
        if (idx < nmain) {
            const int h = idx >> 9, qt = idx & 511;
            if (!odd) {
                const int rp = qt >> 2, cb = qt & 3;
                const int R0 = min(max(2 * rp - 4, 0), 247), C0 = min(max(16 * cb - 8, 0), 32);
                const int qtok = (2 * rp + (r32 >> 4)) * 64 + 16 * cb + (r32 & 15);
                wave_attn<0>(QKV + 768 + h * 64, QKV + 1280 + h * 64, QKV + 1792 + h * 64, OB + 512 + h * 64, N_EVEN, qtok, 9, R0 * 64 + C0, 64, rpbL + h * 465, false, 0.f, vl, lane);
            } else {
                const int ulo = max(0, 4 - qt), uhi = min(8, 515 - qt);
                const float sk = a->in[15][li * 16 + h] * LOG2E;
                wave_attn<1>(QKV + h * 64, QKV + 1024 + (h >> 3) * 64, QKV + 1152 + (h >> 3) * 64, OB + h * 64, N_ODD, 32 * qt + r32, uhi - ulo + 1, 32 * qt - 128 + 32 * ulo, 32, rpbL, true, sk, vl, lane);
            }
        } else {
            const int j = idx - nmain, h = (j >> 3) & (odd ? 15 : 7), qt = j & 7; const int qtok = S_LAT + 32 * qt + r32;
            const bf16_t *q, *k, *v; bf16_t* o; bool sink = false; float sk = 0.f;
            if (odd) { q = QKV + h * 64; k = QKV + 1024 + (h >> 3) * 64; v = QKV + 1152 + (h >> 3) * 64; o = OB + h * 64; sink = true; sk = a->in[15][li * 16 + h] * LOG2E; }
            else if (j < 64) { q = QKV + h * 64; k = QKV + 512 + (h >> 2) * 64; v = QKV + 640 + (h >> 2) * 64; o = OB + h * 64; }
            else { q = QKV + 768 + h * 64; k = QKV + 1280 + h * 64; v = QKV + 1792 + h * 64; o = OB + 512 + h * 64; }
            wave_attn<2>(q, k, v, o, odd ? N_ODD : N_EVEN, qtok, 0, 0, 0, rpbL, sink, sk, vl, lane);
        }
    }
}

#define FRESH_IDS() int tid = threadIdx.x; asm volatile("" : "+v"(tid)); const int lane = tid & 63, wave = __builtin_amdgcn_readfirstlane(tid >> 6); const int gw = bid * 8 + wave, ngw = G * 8; (void)lane; (void)gw; (void)ngw
#define GRID_BAR() do { int tid_b = threadIdx.x; asm volatile("" : "+v"(tid_b)); XcdBarrier xb_; xb_.bar = (unsigned*)(relaunder(ap)->ws + WS_BAR); xb_.x = xb_xcc_id(); xb_.st = (volatile LAS unsigned*)((LAS unsigned char*)lds_raw + LDS_BARST); xcd_barrier(xb_, tid_b); } while (0)
template <int L> __device__ __forceinline__ void run_layer(ArgsP ap, unsigned char* lds_raw, float* dout_unused) {
    constexpr int l = L; constexpr bool odd = (L & 1) != 0, ctx_out = L < 3; constexpr int li = L >> 1;
    constexpr int n_in = odd ? N_ODD : N_EVEN, m_rows = ctx_out ? MT : S_LAT;
    LAS unsigned char* lds = (LAS unsigned char*)lds_raw;
    const int G = gridDim.x, bid = blockIdx.x;
    {
        ArgsP a = relaunder(ap); unsigned char* ws = a->ws; const float* cosT = (const float*)(ws + WS_ROPE);
        pg8::Gemm g{(const bf16_t*)(ws + WS_XN), (const bf16_t*)(ws + WS_WIN), MT, n_in, DM, DM}; pg8::StaticOrder S; S.init(MT, n_in, G, bid);
        pg8::EpiInproj E{(bf16_t*)(ws + WS_R1), n_in, a->in[10] + li * 64, a->in[11] + li * 64, cosT, cosT + 4096, odd ? 0 : 512, odd ? 0 : 640, odd ? 1152 : 640, odd ? 1024 : 512, odd ? 0 : 768, odd ? 0 : 1280, QC2};
        pg8::gemm_phase<pg8::EpiInproj, pg8::StaticOrder, true, true>(lds, g, S, E);
    }
    GRID_BAR();
    if (!odd) {
        FRESH_IDS(); ArgsP a = relaunder(ap); unsigned char* ws = a->ws; const bf16_t* QKV = (const bf16_t*)(ws + WS_R1); bf16_t* OB = (bf16_t*)(ws + WS_O);
        const int vcu = (G % 8 == 0) ? (bid % 8) * (G / 8) + bid / 8 : bid;
        for (int unit = vcu; unit < 512; unit += G) { const int h = unit >> 6, qb = unit & 63;
            attn_body::attn_unit<8>(qb, (const attn_body::bf16*)(QKV + h * 64), (const attn_body::bf16*)(QKV + 512 + (h >> 2) * 64), (const attn_body::bf16*)(QKV + 640 + (h >> 2) * 64),
                                    (attn_body::bf16*)(OB + h * 64), (char*)lds_raw); }
        __syncthreads();
        { const float* rpb = a->in[12] + (size_t)li * 8 * 465; LAS float* rl = (LAS float*)lds;
          for (int i = tid; i < 8 * 465; i += 512) rl[i] = rpb[i] * LOG2E; }
        __syncthreads();
    }
    { FRESH_IDS(); phase_attn_waves(relaunder(ap), l, ctx_out, lds, gw, ngw, wave, lane); }
    GRID_BAR();
    {
        ArgsP a = relaunder(ap); unsigned char* ws = a->ws; const float* ml = (const float*)(ws + WS_MODS) + (size_t)(l * 2) * NMOD;
        { pg8::Gemm g{(const bf16_t*)(ws + WS_O), (const bf16_t*)(ws + WS_WOUT), S_LAT, DM, DM, DM}; pg8::StaticOrder S; S.init(S_LAT, DM, G, bid);
          pg8::EpiResid<false> E{(float*)(ws + WS_XS), ml + 2 * DM, ml + NMOD + 2 * DM, nullptr};
          pg8::gemm_phase<pg8::EpiResid<false>, pg8::StaticOrder, true, true>(lds, g, S, E); }
        if (ctx_out) {
          pg8::Gemm g{(const bf16_t*)(ws + WS_O) + (size_t)S_LAT * DM, (const bf16_t*)(ws + WS_WOUT), N_CTX, DM, 256, DM}; typedef pg8::SplitKOrder<4, 4, 256, 64> SKO; SKO S; S.init(G, bid);
          pg8::EpiResid<true> E{(float*)(ws + WS_XS), ml + 2 * DM, ml + NMOD + 2 * DM, (float*)(ws + WS_PART)};
          pg8::gemm_phase<pg8::EpiResid<true>, SKO, true, true>(lds, g, S, E); }
    }
    GRID_BAR();
    { FRESH_IDS(); ArgsP a = relaunder(ap); const float* ml = (const float*)(a->ws + WS_MODS) + (size_t)(l * 2) * NMOD;
      phase_ln(a, m_rows, 4, ml + NMOD + 2 * DM, a->in[6] + (size_t)(l * 2) * DM, a->in[7] + (size_t)(l * 2) * DM, ml + 3 * DM, nullptr, gw, ngw, lane); }
    GRID_BAR();
    {
        ArgsP a = relaunder(ap); unsigned char* ws = a->ws;
        pg8::Gemm g{(const bf16_t*)(ws + WS_XN), (const bf16_t*)(ws + WS_WUP), m_rows, NU, DM, DM}; pg8::ConvOrder S; S.init(ctx_out ? 67 : 65, NU, G, bid);
        pg8::EpiUpConv E{(bf16_t*)(ws + WS_HF2), a->in[17] + (size_t)l * 3 * NU, a->in[18] + (size_t)l * NU, (LAS float*)(lds + 131072)};
        pg8::gemm_phase<pg8::EpiUpConv, pg8::ConvOrder, true, true>(lds, g, S, E);
    }
    GRID_BAR();
    {
        ArgsP a = relaunder(ap); unsigned char* ws = a->ws; const float* ml = (const float*)(ws + WS_MODS) + (size_t)(l * 2) * NMOD;
        { pg8::Gemm g{(const bf16_t*)(ws + WS_HF2), (const bf16_t*)(ws + WS_WDN), S_LAT, DM, FF, FF}; pg8::StaticOrder S; S.init(S_LAT, DM, G, bid);
          pg8::EpiResid<false> E{(float*)(ws + WS_XS), ml + 5 * DM, ml + NMOD + 5 * DM, nullptr};
          pg8::gemm_phase<pg8::EpiResid<false>, pg8::StaticOrder, true, true>(lds, g, S, E); }
        if (ctx_out) {
          pg8::Gemm g{(const bf16_t*)(ws + WS_HF2) + (size_t)S_LAT * FF, (const bf16_t*)(ws + WS_WDN), N_CTX, DM, 256, FF}; typedef pg8::SplitKOrder<4, 11, 256, 64> SKO; SKO S; S.init(G, bid);
          pg8::EpiResid<true> E{(float*)(ws + WS_XS), ml + 5 * DM, ml + NMOD + 5 * DM, (float*)(ws + WS_PART)};
          pg8::gemm_phase<pg8::EpiResid<true>, SKO, true, true>(lds, g, S, E); }
    }
    GRID_BAR();
    { FRESH_IDS(); ArgsP a = relaunder(ap);
      if (l < 3) { phase_ln(a, m_rows, 11, (const float*)(a->ws + WS_MODS) + (size_t)(l * 2 + 1) * NMOD + 5 * DM, a->in[6] + (size_t)(l * 2 + 1) * DM, a->in[7] + (size_t)(l * 2 + 1) * DM, (const float*)(a->ws + WS_MODS) + (size_t)((l + 1) * 2) * NMOD, nullptr, gw, ngw, lane);
                   convert_layer(relaunder(ap), l + 1, lds, gw, ngw, wave, lane); GRID_BAR(); }
      else phase_ln(a, S_LAT, 0, nullptr, a->in[6] + (size_t)(l * 2 + 1) * DM, a->in[7] + (size_t)(l * 2 + 1) * DM, nullptr, a->out, gw, ngw, lane); }
}

__global__ void __launch_bounds__(512, 2) mk_fwd(Args a_by_value) {
    extern __shared__ __attribute__((aligned(16))) unsigned char lds_raw[];
    cg::grid_group grid = cg::this_grid();
    const ArgsP ap = (ArgsP)__builtin_amdgcn_kernarg_segment_ptr();
    {
        LAS unsigned char* lds = (LAS unsigned char*)lds_raw;
        const int tid = threadIdx.x, lane = tid & 63, wave = __builtin_amdgcn_readfirstlane(tid >> 6);
        const int G = gridDim.x, bid = blockIdx.x, gw = bid * 8 + wave, ngw = G * 8;
        if (tid < 16) ((LAS unsigned*)(lds + LDS_BARST))[tid] = 0u;
        __syncthreads();
        (void)xcd_barrier_post((unsigned*)(relaunder(ap)->ws + WS_BAR), (volatile LAS unsigned*)(lds + LDS_BARST), tid);
        phase_adaln(relaunder(ap), lds, bid, G, tid, wave, lane);
        if (bid == G - 1) rope_tables(relaunder(ap), tid);
        convert_layer(relaunder(ap), 0, lds, gw, ngw, wave, lane);
        grid.sync();
        phase_init(relaunder(ap), gw, ngw, lane);
        GRID_BAR();
    }
    run_layer<0>(ap, lds_raw, nullptr);
    run_layer<1>(ap, lds_raw, nullptr);
    run_layer<2>(ap, lds_raw, nullptr);
    run_layer<3>(ap, lds_raw, nullptr);
}

extern "C" void kernel_launch(void* const* d_in, const int* in_sizes, int n_in, void* d_out, int out_size, void* d_ws, size_t ws_size, hipStream_t stream) {
    static int grid = 0;
    if (grid == 0) {
        if (n_in != 20 || out_size != S_LAT * DM || ws_size < WS_END) { fprintf(stderr, "kernel_launch: unexpected problem (n_in %d, out %d, ws %zu < %zu)\n", n_in, out_size, ws_size, (size_t)WS_END); grid = -1; return; }
        int dev = 0, cus = 0, per_cu = 0;
        (void)hipGetDevice(&dev); (void)hipDeviceGetAttribute(&cus, hipDeviceAttributeMultiprocessorCount, dev);
        if (hipFuncSetAttribute((const void*)mk_fwd, hipFuncAttributeMaxDynamicSharedMemorySize, LDS_BYTES) != hipSuccess) { fprintf(stderr, "kernel_launch: hipFuncSetAttribute failed\n"); grid = -1; return; }
        if (hipOccupancyMaxActiveBlocksPerMultiprocessor(&per_cu, (const void*)mk_fwd, 512, LDS_BYTES) != hipSuccess || per_cu < 1) { fprintf(stderr, "kernel_launch: occupancy query says %d\n", per_cu); per_cu = 1; }
        (void)hipGetLastError();
        grid = cus * 1;
        if (grid <= 0) grid = 256;
    }
    if (grid < 0) return;
    Args a{};
    for (int i = 0; i < 20; ++i) a.in[i] = (const float*)d_in[i];
    a.out = (float*)d_out; a.ws = (unsigned char*)d_ws;
    if (hipMemsetAsync((char*)d_ws + WS_BAR, 0, 16384, stream) != hipSuccess) { fprintf(stderr, "kernel_launch: memset failed\n"); return; }
    void* args[] = {&a};
    hipError_t e = hipLaunchCooperativeKernel((const void*)mk_fwd, dim3(grid), dim3(512), args, LDS_BYTES, stream);
    if (e != hipSuccess) fprintf(stderr, "cooperative launch failed: %s (grid %d)\n", hipGetErrorString(e), grid);
}
```
